# Optimizing an MI355X kernel written in HIP

```python
import jax, jax.numpy as jnp
from jax import lax
import numpy as np

D_MODEL = 2048
BATCH = 2
SEQ = 4096
DEPTH = 1

CHUNK = 64

GLA_HEADS = 4
GLA_DK = 128
GLA_DV = 256
GLA_QK = GLA_HEADS * GLA_DK
GLA_V = GLA_HEADS * GLA_DV
GLA_LORA = 16
GLA_TAU = 16.0

RWKV_HEADS = 16
RWKV_HD = 64
RWKV_W = RWKV_HEADS * RWKV_HD
DECAY_LORA = 96
AAA_LORA = 96
GATE_LORA = 256
GN_EPS = 64e-5

N_BRANCH = 2
D_FF = 5632
NORM_EPS = 1e-6

GLA_SPLITS = (GLA_QK, GLA_QK, GLA_V, GLA_V, GLA_LORA)
GLA_IN = 2 * GLA_QK + 2 * GLA_V + GLA_LORA
RWKV_SPLITS = (RWKV_W, RWKV_W, RWKV_W, DECAY_LORA, AAA_LORA, GATE_LORA)
RWKV_IN = 3 * RWKV_W + DECAY_LORA + AAA_LORA + GATE_LORA
D_IN = GLA_IN + RWKV_IN + N_BRANCH * D_MODEL
BRANCH_IN = GLA_V + RWKV_W

kernel_name = "hybrid_gla_rwkv7_macaron_block"


def _split(p, sizes):
    out, off = [], 0
    for s in sizes:
        out.append(p[..., off:off + s])
        off += s
    return out


def rmsnorm(x, g):
    xf = x.astype(jnp.float32)
    y = xf * lax.rsqrt(jnp.mean(xf * xf, axis=-1, keepdims=True) + NORM_EPS)
    return (y * g.astype(jnp.float32)).astype(x.dtype)


def swiglu(h, wg, wu, wd):
    return (jax.nn.silu(h @ wg) * (h @ wu)) @ wd


def token_shift(p, mu):
    prev = jnp.pad(p, ((0, 0), (1, 0), (0, 0)))[:, :-1]
    return p + mu * (prev - p)


def gla_branch(q, k, v, r, a_down, w_a2, b_a, gn_w):
    B, S, _ = q.shape
    nc = S // CHUNK
    f32 = jnp.float32
    log_alpha = jax.nn.log_sigmoid(a_down.astype(f32) @ w_a2.astype(f32) + b_a.astype(f32)) / GLA_TAU
    shp = (B, nc, CHUNK, GLA_HEADS, GLA_DK)
    qf = q.astype(f32).reshape(shp) * (GLA_DK ** -0.5)
    kf = k.astype(f32).reshape(shp)
    vf = v.astype(f32).reshape(B, nc, CHUNK, GLA_HEADS, GLA_DV)
    cum = jnp.cumsum(log_alpha.reshape(shp), axis=2)
    total = cum[:, :, -1]
    kdec = kf * jnp.exp(total[:, :, None] - cum)
    u = jnp.einsum('bnchk,bnchv->nbhkv', kdec, vf)

    def step(state, inp):
        lt, uc = inp
        state = jnp.exp(lt)[..., None] * state + uc
        return state, state

    s0 = jnp.zeros((B, GLA_HEADS, GLA_DK, GLA_DV), f32)
    _, states = lax.scan(step, s0, (jnp.moveaxis(total, 1, 0), u))
    o = jnp.einsum('bnchk,nbhkv->bnchv', qf, states)
    o = o * lax.rsqrt(jnp.mean(o * o, axis=-1, keepdims=True) + NORM_EPS) * gn_w.astype(f32)
    o = o.reshape(B, S, GLA_V) * jax.nn.silu(r.astype(f32))
    return o.astype(q.dtype)


def rwkv7_branch(r, k, v, wd, ad, gd, w0, w_w2, a0, w_a2, w_g2, k_k, k_a, r_k, lnx_w, lnx_b):
    B, S, _ = r.shape
    f32 = jnp.float32
    r, k, v = r.astype(f32), k.astype(f32), v.astype(f32)
    w_raw = w0.astype(f32) + jnp.tanh(wd.astype(f32)) @ w_w2.astype(f32)
    log_w = -jnp.exp(-jax.nn.softplus(-w_raw) - 0.5)
    a = jax.nn.sigmoid(a0.astype(f32) + ad.astype(f32) @ w_a2.astype(f32))
    g = jax.nn.sigmoid(gd.astype(f32)) @ w_g2.astype(f32)
    hs = (B, S, RWKV_HEADS, RWKV_HD)
    kk = (k * k_k.astype(f32)).reshape(hs)
    kk = kk / jnp.maximum(jnp.linalg.norm(kk, axis=-1, keepdims=True), 1e-12)
    k = k * (1.0 + (a - 1.0) * k_a.astype(f32))
    rh, kh, vh, ah = r.reshape(hs), k.reshape(hs), v.reshape(hs), a.reshape(hs)
    decay = jnp.exp(log_w).reshape(hs)
    b = kk * ah

    def step(state, inp):
        r_t, w_t, k_t, v_t, kk_t, b_t = inp
        sa = jnp.einsum('bhvk,bhk->bhv', state, kk_t)
        state = (state * w_t[:, :, None, :] - sa[..., None] * b_t[:, :, None, :]
                 + v_t[..., None] * k_t[:, :, None, :])
        return state, jnp.einsum('bhvk,bhk->bhv', state, r_t)

    xs = tuple(jnp.moveaxis(t, 1, 0) for t in (rh, decay, kh, vh, kk, b))
    s0 = jnp.zeros((B, RWKV_HEADS, RWKV_HD, RWKV_HD), f32)
    _, y = lax.scan(step, s0, xs)
    y = jnp.moveaxis(y, 0, 1)
    mu = jnp.mean(y, axis=-1, keepdims=True)
    var = jnp.mean(jnp.square(y - mu), axis=-1, keepdims=True)
    yn = ((y - mu) * lax.rsqrt(var + GN_EPS)).reshape(B, S, RWKV_W)
    yn = yn * lnx_w.astype(f32) + lnx_b.astype(f32)
    bonus = (jnp.sum(rh * kh * r_k.astype(f32), axis=-1, keepdims=True) * vh).reshape(B, S, RWKV_W)
    return ((yn + bonus) * g).astype(r.dtype)


def hybrid_mixer(h, w_in, gla_w_a2, gla_b_a, gla_gn_w, rwkv_mu, rwkv_w0, rwkv_w_w2,
                 rwkv_a0, rwkv_w_a2, rwkv_w_g2, rwkv_k_k, rwkv_k_a, rwkv_r_k,
                 rwkv_lnx_w, rwkv_lnx_b, gate_b, w_branch, w_out):
    p = h @ w_in
    gla_p = p[..., :GLA_IN]
    rw_p = token_shift(p[..., GLA_IN:GLA_IN + RWKV_IN], rwkv_mu)
    gate_p = p[..., GLA_IN + RWKV_IN:]
    gq, gk, gv, gr, gad = _split(gla_p, GLA_SPLITS)
    rr, rk, rv, rwd, rad, rgd = _split(rw_p, RWKV_SPLITS)
    o_gla = gla_branch(gq, gk, gv, gr, gad, gla_w_a2, gla_b_a, gla_gn_w)
    o_rw = rwkv7_branch(rr, rk, rv, rwd, rad, rgd, rwkv_w0, rwkv_w_w2, rwkv_a0, rwkv_w_a2,
                        rwkv_w_g2, rwkv_k_k, rwkv_k_a, rwkv_r_k, rwkv_lnx_w, rwkv_lnx_b)
    gates = jax.nn.sigmoid((gate_p + gate_b).astype(jnp.float32))
    y_gla = (o_gla @ w_branch[:GLA_V]).astype(jnp.float32)
    y_rw = (o_rw @ w_branch[GLA_V:]).astype(jnp.float32)
    merged = gates[..., :D_MODEL] * y_gla + gates[..., D_MODEL:] * y_rw
    return merged.astype(h.dtype) @ w_out


def setup_inputs(seed: int = 0) -> dict:
    key = jax.random.key(seed)
    ks = iter(jax.random.split(key, 40))
    L, D = DEPTH, D_MODEL

    def nrm(shape, scale):
        return scale * jax.random.normal(next(ks), shape, jnp.float32)

    def gain(shape):
        return 1.0 + nrm(shape, 0.02)

    return {
        "x": nrm((BATCH, SEQ, D), 1.0),
        "ffn1_norm": gain((L, D)),
        "ffn1_wg": nrm((L, D, D_FF), D ** -0.5),
        "ffn1_wu": nrm((L, D, D_FF), D ** -0.5),
        "ffn1_wd": nrm((L, D_FF, D), D_FF ** -0.5),
        "mix_norm": gain((L, D)),
        "w_in": nrm((L, D, D_IN), D ** -0.5),
        "gla_w_a2": nrm((L, GLA_LORA, GLA_QK), GLA_LORA ** -0.5),
        "gla_b_a": nrm((L, GLA_QK), 0.1),
        "gla_gn_w": gain((L, GLA_DV)),
        "rwkv_mu": jax.random.uniform(next(ks), (L, RWKV_IN), jnp.float32, 0.0, 1.0),
        "rwkv_w0": -2.0 + nrm((L, RWKV_W), 0.5),
        "rwkv_w_w2": nrm((L, DECAY_LORA, RWKV_W), 0.3 * DECAY_LORA ** -0.5),
        "rwkv_a0": nrm((L, RWKV_W), 0.1),
        "rwkv_w_a2": nrm((L, AAA_LORA, RWKV_W), 0.3 * AAA_LORA ** -0.5),
        "rwkv_w_g2": nrm((L, GATE_LORA, RWKV_W), GATE_LORA ** -0.5),
        "rwkv_k_k": 0.85 + nrm((L, RWKV_W), 0.05),
        "rwkv_k_a": gain((L, RWKV_W)),
        "rwkv_r_k": nrm((L, RWKV_HEADS, RWKV_HD), 0.1),
        "rwkv_lnx_w": gain((L, RWKV_W)),
        "rwkv_lnx_b": nrm((L, RWKV_W), 0.01),
        "gate_b": nrm((L, N_BRANCH * D), 0.1),
        "w_branch": nrm((L, BRANCH_IN, D), GLA_V ** -0.5),
        "w_out": nrm((L, D, D), D ** -0.5),
        "ffn2_norm": gain((L, D)),
        "ffn2_wg": nrm((L, D, D_FF), D ** -0.5),
        "ffn2_wu": nrm((L, D, D_FF), D ** -0.5),
        "ffn2_wd": nrm((L, D_FF, D), D_FF ** -0.5),
        "final_norm": gain((D,)),
    }


def reference(x, ffn1_norm, ffn1_wg, ffn1_wu, ffn1_wd, mix_norm, w_in, gla_w_a2, gla_b_a,
              gla_gn_w, rwkv_mu, rwkv_w0, rwkv_w_w2, rwkv_a0, rwkv_w_a2, rwkv_w_g2, rwkv_k_k,
              rwkv_k_a, rwkv_r_k, rwkv_lnx_w, rwkv_lnx_b, gate_b, w_branch, w_out,
              ffn2_norm, ffn2_wg, ffn2_wu, ffn2_wd, final_norm):
    for l in range(DEPTH):
        h = rmsnorm(x, ffn1_norm[l])
        x = x + 0.5 * swiglu(h, ffn1_wg[l], ffn1_wu[l], ffn1_wd[l])
        h = rmsnorm(x, mix_norm[l])
        x = x + hybrid_mixer(h, w_in[l], gla_w_a2[l], gla_b_a[l], gla_gn_w[l], rwkv_mu[l],
                             rwkv_w0[l], rwkv_w_w2[l], rwkv_a0[l], rwkv_w_a2[l], rwkv_w_g2[l],
                             rwkv_k_k[l], rwkv_k_a[l], rwkv_r_k[l], rwkv_lnx_w[l], rwkv_lnx_b[l],
                             gate_b[l], w_branch[l], w_out[l])
        h = rmsnorm(x, ffn2_norm[l])
        x = x + 0.5 * swiglu(h, ffn2_wg[l], ffn2_wu[l], ffn2_wd[l])
    return rmsnorm(x, final_norm)
```

```cpp
#include <hip/hip_runtime.h>
#include <hip/hip_cooperative_groups.h>
#include <cstdio>
#include <cstdint>
namespace cg = cooperative_groups;
namespace pg8 {
#define PG8_LAS __attribute__((address_space(3)))
typedef unsigned short bf16_t;
typedef short bf16x8 __attribute__((ext_vector_type(8)));
typedef float f32x4 __attribute__((ext_vector_type(4)));
typedef unsigned u32x4 __attribute__((ext_vector_type(4)));
constexpr int BM = 256, BK = 64, HALF = 128, HTB = HALF * BK * 2  , STAGE_BYTES = 8 * HTB, NXCD = 8, WGM = 8;

__host__ __device__ __forceinline__ int lds_byte(int r, int c) { const int st = (r >> 4) * 2 + (c >> 5), rr = r & 15, cc = c & 31, ob = rr * 64 + cc * 2; return st * 1024 + (ob ^ (((ob >> 9) & 1) << 5)); }
__host__ __device__ __forceinline__ void stage_rc(int b, int& R, int& C) { const int st = b / 1024, sb = b % 1024, swz = sb ^ (((sb >> 9) & 1) << 5); R = (st >> 1) * 16 + swz / 64; C = (st & 1) * 32 + (swz % 64) / 2; }
__host__ __device__ __forceinline__ int perm32(int rho) { const int n = rho >> 4, i = rho & 15; return 8 * (i >> 2) + 4 * n + (i & 3); }

struct Unit { int pm, pn; };
struct Gemm { const bf16_t* A; const bf16_t* Bt; int M, N, K; int lda, ldb; };

struct StaticOrder {
    int nM, nN, nwg, G, c;
    __host__ __device__ void init(int M, int N, int G_, int c_) { nM = M / BM; nN = N / BM; nwg = nM * nN; G = G_; c = c_; }
    __host__ __device__ bool next(int i, Unit& u) const {
        const long L = (long)i * G + c; if (L >= nwg) return false;
        int wgid = (int)L; { const int q = nwg / NXCD, r = nwg % NXCD, xcd = wgid % NXCD, off = wgid / NXCD; wgid = (xcd < r ? xcd * (q + 1) : r * (q + 1) + (xcd - r) * q) + off; }
        const int nig = WGM * nN, gid = wgid / nig, fm = gid * WGM, gsz = (nM - fm) < WGM ? (nM - fm) : WGM;
        u.pm = fm + ((wgid % nig) % gsz); u.pn = (wgid % nig) / gsz; return true;
    }
    __device__ __forceinline__ void a_ready(const Unit&) const {}
    __device__ __forceinline__ void done(const Unit&) const {}
};

struct LoraOrder { StaticOrder S;
    __device__ bool next(int i, Unit& u) const { if (!S.next(i, u)) return false; if (u.pn >= 8) u.pm += 32; return true; }
    __device__ __forceinline__ void a_ready(const Unit&) const {}
    __device__ __forceinline__ void done(const Unit&) const {} };
__device__ __forceinline__ unsigned cvt_pk_bf16(float lo, float hi) { unsigned r; asm volatile("v_cvt_pk_bf16_f32 %0, %1, %2" : "=v"(r) : "v"(lo), "v"(hi)); return r; }
typedef float f32x2 __attribute__((ext_vector_type(2)));
typedef unsigned u32x2 __attribute__((ext_vector_type(2)));
__device__ __forceinline__ float fast_sigmoid(float x) { return __builtin_amdgcn_rcpf(1.0f + __builtin_amdgcn_exp2f(-1.4426950408889634f * x)); }
__device__ __forceinline__ float fast_silu(float x) { return x * fast_sigmoid(x); }
__device__ __forceinline__ float bf_lo(unsigned u) { return __uint_as_float(u << 16); }
__device__ __forceinline__ float bf_hi(unsigned u) { return __uint_as_float(u & 0xffff0000u); }

struct EpiSwiglu {
    static constexpr bool PERM = true, AFTER_DRAIN = false;
    bf16_t* O; int ldc; const float* ss;
    __device__ __forceinline__ void operator()(const f32x4 (&acc)[2][2][4][2], const Unit& u, int wr, int wc, int fr, int fq) const {
        const int row0 = u.pm * BM + wr * 64 + fr, col0 = u.pn * HALF + wc * 32 + 8 * fq;
        float rsv[2][4];
#pragma unroll
        for (int ai = 0; ai < 2; ++ai)
#pragma unroll
            for (int m = 0; m < 4; ++m) rsv[ai][m] = ss ? ss[row0 + ai * HALF + m * 16] : 0.f;
#pragma unroll
        for (int ai = 0; ai < 2; ++ai)
#pragma unroll
            for (int m = 0; m < 4; ++m) {
                bf16_t* rowp = O + (size_t)(row0 + ai * HALF + m * 16) * ldc + col0;
                const float rs = ss ? rsqrtf(rsv[ai][m] * (1.0f / 2048.0f) + 1e-6f) : 1.0f;
                const f32x4 g0 = acc[ai][0][m][0] * rs, g1 = acc[ai][0][m][1] * rs, u0 = acc[ai][1][m][0] * rs, u1 = acc[ai][1][m][1] * rs;
                u32x4 w;
                w.x = cvt_pk_bf16(fast_silu(g0[0]) * u0[0], fast_silu(g0[1]) * u0[1]); w.y = cvt_pk_bf16(fast_silu(g0[2]) * u0[2], fast_silu(g0[3]) * u0[3]);
                w.z = cvt_pk_bf16(fast_silu(g1[0]) * u1[0], fast_silu(g1[1]) * u1[1]); w.w = cvt_pk_bf16(fast_silu(g1[2]) * u1[2], fast_silu(g1[3]) * u1[3]);
                *(u32x4*)rowp = w;
            }
    }
};
struct EpiResid {
    static constexpr bool PERM = true, AFTER_DRAIN = false;
    const float* base; float* out; int ldc; float scale;
    bf16_t* Hn; const float* gn; float* ss;
    __device__ __forceinline__ void operator()(const f32x4 (&acc)[2][2][4][2], const Unit& u, int wr, int wc, int fr, int fq) const {
        const int row0 = u.pm * BM + wr * 64 + fr, col0 = u.pn * BM + wc * 32 + 8 * fq;
#pragma unroll
        for (int ai = 0; ai < 2; ++ai)
#pragma unroll
            for (int m = 0; m < 4; ++m) {
                const size_t off = (size_t)(row0 + ai * HALF + m * 16) * ldc + col0; float sq = 0.f;
#pragma unroll
                for (int bj = 0; bj < 2; ++bj) {
                    const f32x4 b0 = *(const f32x4*)(base + off + bj * HALF), b1 = *(const f32x4*)(base + off + bj * HALF + 4);
                    const f32x4 o0 = b0 + acc[ai][bj][m][0] * scale, o1 = b1 + acc[ai][bj][m][1] * scale;
                    if (out) { *(f32x4*)(out + off + bj * HALF) = o0; *(f32x4*)(out + off + bj * HALF + 4) = o1; }
                    if (Hn) { const f32x4 g0 = *(const f32x4*)(gn + col0 + bj * HALF), g1 = *(const f32x4*)(gn + col0 + bj * HALF + 4);
                        sq += (o0[0] * o0[0] + o0[1] * o0[1]) + (o0[2] * o0[2] + o0[3] * o0[3]) + (o1[0] * o1[0] + o1[1] * o1[1]) + (o1[2] * o1[2] + o1[3] * o1[3]);
                        u32x4 w; w.x = cvt_pk_bf16(o0[0] * g0[0], o0[1] * g0[1]); w.y = cvt_pk_bf16(o0[2] * g0[2], o0[3] * g0[3]); w.z = cvt_pk_bf16(o1[0] * g1[0], o1[1] * g1[1]); w.w = cvt_pk_bf16(o1[2] * g1[2], o1[3] * g1[3]);
                        *(u32x4*)(Hn + off + bj * HALF) = w; }
                }
                if (Hn) { sq += __shfl_xor(sq, 16); sq += __shfl_xor(sq, 32); if (fq == 0) atomicAdd(ss + row0 + ai * HALF + m * 16, sq); }
            }
    }
};
struct EpiWin {
    static constexpr bool PERM = true, AFTER_DRAIN = false;
    bf16_t* O; int ldc; const float* gate_b; int gt_lo, gt_hi; const float* ss;
    __device__ __forceinline__ void operator()(const f32x4 (&acc)[2][2][4][2], const Unit& u, int wr, int wc, int fr, int fq) const {
        const int row0 = u.pm * BM + wr * 64 + fr, col0 = u.pn * BM + wc * 32 + 8 * fq;
        const bool gate = (u.pn >= gt_lo && u.pn < gt_hi);
        float rsv[2][4];
#pragma unroll
        for (int ai = 0; ai < 2; ++ai)
#pragma unroll
            for (int m = 0; m < 4; ++m) rsv[ai][m] = ss ? ss[row0 + ai * HALF + m * 16] : 0.f;
        f32x4 bv[2][2];
#pragma unroll
        for (int bj = 0; bj < 2; ++bj)
#pragma unroll
            for (int n = 0; n < 2; ++n) bv[bj][n] = gate ? *(const f32x4*)(gate_b + (col0 - gt_lo * BM) + bj * HALF + 4 * n) : (f32x4){0.f, 0.f, 0.f, 0.f};
#pragma unroll
        for (int ai = 0; ai < 2; ++ai)
#pragma unroll
            for (int m = 0; m < 4; ++m) {
                bf16_t* rowp = O + (size_t)(row0 + ai * HALF + m * 16) * ldc + col0;
                const float rs = ss ? rsqrtf(rsv[ai][m] * (1.0f / 2048.0f) + 1e-6f) : 1.0f;
#pragma unroll
                for (int bj = 0; bj < 2; ++bj) {
                    f32x4 v0 = acc[ai][bj][m][0] * rs + bv[bj][0], v1 = acc[ai][bj][m][1] * rs + bv[bj][1];
                    if (gate) {
#pragma unroll
                        for (int j = 0; j < 4; ++j) { v0[j] = fast_sigmoid(v0[j]); v1[j] = fast_sigmoid(v1[j]); }
                    }
                    u32x4 w; w.x = cvt_pk_bf16(v0[0], v0[1]); w.y = cvt_pk_bf16(v0[2], v0[3]); w.z = cvt_pk_bf16(v1[0], v1[1]); w.w = cvt_pk_bf16(v1[2], v1[3]);
                    *(u32x4*)(rowp + bj * HALF) = w;
                }
            }
    }
};
struct EpiLora {
    static constexpr bool PERM = true, AFTER_DRAIN = false;
    bf16_t* O; int ldc; const float* w0; const float* a0;
    __device__ __forceinline__ void operator()(const f32x4 (&acc)[2][2][4][2], const Unit& u, int wr, int wc, int fr, int fq) const {
        const int row0 = (u.pm & 31) * BM + wr * 64 + fr, col0 = u.pn * BM + wc * 32 + 8 * fq;
        const int kind = u.pn >> 2, cl0 = col0 - kind * 1024;
        const float* bp = kind == 0 ? w0 : a0;
        f32x4 bv[2][2];
#pragma unroll
        for (int bj = 0; bj < 2; ++bj)
#pragma unroll
            for (int n = 0; n < 2; ++n) bv[bj][n] = kind < 2 ? *(const f32x4*)(bp + cl0 + bj * HALF + 4 * n) : (f32x4){0.f, 0.f, 0.f, 0.f};
#pragma unroll
        for (int ai = 0; ai < 2; ++ai)
#pragma unroll
            for (int m = 0; m < 4; ++m) {
                bf16_t* rowp = O + (size_t)(row0 + ai * HALF + m * 16) * ldc + col0;
#pragma unroll
                for (int bj = 0; bj < 2; ++bj) {
                    f32x4 v0 = acc[ai][bj][m][0] + bv[bj][0], v1 = acc[ai][bj][m][1] + bv[bj][1];
                    if (kind == 0) {
#pragma unroll
                        for (int j = 0; j < 4; ++j) { v0[j] = 1.0f - __builtin_amdgcn_exp2f(-0.875053085f * fast_sigmoid(v0[j])); v1[j] = 1.0f - __builtin_amdgcn_exp2f(-0.875053085f * fast_sigmoid(v1[j])); }
                    } else if (kind == 1) {
#pragma unroll
                        for (int j = 0; j < 4; ++j) { v0[j] = fast_sigmoid(v0[j]); v1[j] = fast_sigmoid(v1[j]); }
                    }
                    u32x4 w; w.x = cvt_pk_bf16(v0[0], v0[1]); w.y = cvt_pk_bf16(v0[2], v0[3]); w.z = cvt_pk_bf16(v1[0], v1[1]); w.w = cvt_pk_bf16(v1[2], v1[3]);
                    *(u32x4*)(rowp + bj * HALF) = w;
                }
            }
    }
};
template <bool ADD> struct EpiGate {
    static constexpr bool PERM = true, AFTER_DRAIN = false;
    const bf16_t* G; int ldg; bf16_t* T; int ldc;
    __device__ __forceinline__ void operator()(const f32x4 (&acc)[2][2][4][2], const Unit& u, int wr, int wc, int fr, int fq) const {
        const int row0 = u.pm * BM + wr * 64 + fr, col0 = u.pn * BM + wc * 32 + 8 * fq;
#pragma unroll
        for (int ai = 0; ai < 2; ++ai)
#pragma unroll
            for (int mp = 0; mp < 2; ++mp) {
                u32x4 gvv[2][2], tvv[2][2];
#pragma unroll
                for (int mm = 0; mm < 2; ++mm)
#pragma unroll
                    for (int bj = 0; bj < 2; ++bj) { const size_t r = (size_t)(row0 + ai * HALF + (2 * mp + mm) * 16); gvv[mm][bj] = *(const u32x4*)(G + r * ldg + col0 + bj * HALF);
                        if (ADD) tvv[mm][bj] = *(const u32x4*)(T + r * ldc + col0 + bj * HALF); }
#pragma unroll
                for (int mm = 0; mm < 2; ++mm) { const int m = 2 * mp + mm; const size_t r = (size_t)(row0 + ai * HALF + m * 16);
#pragma unroll
                    for (int bj = 0; bj < 2; ++bj) {
                        const u32x4 gv = gvv[mm][bj];
                        const f32x4 a0 = acc[ai][bj][m][0], a1 = acc[ai][bj][m][1];
                        float o[8] = {bf_lo(gv.x) * a0[0], bf_hi(gv.x) * a0[1], bf_lo(gv.y) * a0[2], bf_hi(gv.y) * a0[3], bf_lo(gv.z) * a1[0], bf_hi(gv.z) * a1[1], bf_lo(gv.w) * a1[2], bf_hi(gv.w) * a1[3]};
                        bf16_t* tp = T + r * ldc + col0 + bj * HALF;
                        if (ADD) { const u32x4 tv = tvv[mm][bj];
                            o[0] += bf_lo(tv.x); o[1] += bf_hi(tv.x); o[2] += bf_lo(tv.y); o[3] += bf_hi(tv.y); o[4] += bf_lo(tv.z); o[5] += bf_hi(tv.z); o[6] += bf_lo(tv.w); o[7] += bf_hi(tv.w); }
                        u32x4 w; w.x = cvt_pk_bf16(o[0], o[1]); w.y = cvt_pk_bf16(o[2], o[3]); w.z = cvt_pk_bf16(o[4], o[5]); w.w = cvt_pk_bf16(o[6], o[7]);
                        *(u32x4*)tp = w;
                    }
                }
            }
    }
};
template <class Epi, class Sched, bool ALIGN_EPI = false, bool SP2 = false>
__device__ __forceinline__ void gemm_phase(PG8_LAS unsigned char* lds, const Gemm g, const Sched& S, const Epi& E) {
    const int tid = threadIdx.x, wid = __builtin_amdgcn_readfirstlane(tid >> 6), lane = tid & 63, wr = wid >> 2, wc = wid & 3, fr = lane & 15, fq = lane >> 4;
    const int K = g.K, nt = K / BK, LDA = g.lda ? g.lda : K, LDB = g.ldb ? g.ldb : K;
    unsigned voffA[2], voffB[2];
#pragma unroll
    for (int i = 0; i < 2; ++i) { int R, C; stage_rc(tid * 16 + i * 8192, R, C); const int Rb = Epi::PERM ? ((R & ~31) + perm32(R & 31)) : R;
        voffA[i] = (unsigned)(R * LDA + C) * 2u; voffB[i] = (unsigned)(Rb * LDB + C) * 2u; }
    const size_t kstep = (size_t)(BK * 2);
    const size_t hstepA = (size_t)HALF * LDA * 2, hstepB = (size_t)HALF * LDB * 2;
    const size_t tstepA = 2 * hstepA, tstepB = 2 * hstepB;
    const unsigned ldsw = (unsigned)wid * 1024u;
    const int aoff = lds_byte(wr * 64 + fr, fq * 8), boff = lds_byte(wc * 32 + fr, fq * 8);
#define PG8_SA(b, h) (((b) * 2 + (h)) * HTB)
#define PG8_SB(b, h) ((4 + (b) * 2 + (h)) * HTB)
#define PG8_STAGE(bufoff, gbase, voff) do { _Pragma("unroll") for (int _i = 0; _i < 2; ++_i) \
        __builtin_amdgcn_global_load_lds((const unsigned*)((const char*)(gbase) + (voff)[_i]), (PG8_LAS unsigned*)(lds + (bufoff) + ldsw + _i * 8192), 16, 0, 0); } while (0)
#define PG8_LDA(dst, b, h) do { _Pragma("unroll") for (int m = 0; m < 4; ++m) _Pragma("unroll") for (int k = 0; k < 2; ++k) dst[m][k] = *(const PG8_LAS bf16x8*)(lds + PG8_SA(b, h) + aoff + m * 2048 + k * 1024); } while (0)
#define PG8_LDB(dst, b, h) do { _Pragma("unroll") for (int n = 0; n < 2; ++n) _Pragma("unroll") for (int k = 0; k < 2; ++k) dst[n][k] = *(const PG8_LAS bf16x8*)(lds + PG8_SB(b, h) + boff + n * 2048 + k * 1024); } while (0)
#define PG8_MMA(ai, bj, At, Bt) do { __builtin_amdgcn_s_setprio(1); _Pragma("unroll") for (int m = 0; m < 4; ++m) _Pragma("unroll") for (int n = 0; n < 2; ++n) _Pragma("unroll") for (int k = 0; k < 2; ++k) \
        acc[ai][bj][m][n] = __builtin_amdgcn_mfma_f32_16x16x32_bf16(Bt[n][k], At[m][k], acc[ai][bj][m][n], 0, 0, 0); __builtin_amdgcn_s_setprio(0); } while (0)
#define PG8_WAIT_V(n) asm volatile("s_waitcnt vmcnt(" #n ")" ::: "memory")
#define PG8_WAIT_L(n) asm volatile("s_waitcnt lgkmcnt(" #n ")" ::: "memory")
#define PG8_BAR __builtin_amdgcn_s_barrier()
#define PG8_SCHED __builtin_amdgcn_sched_barrier(0)
    Unit cur, nxt; int ui = 0;
    if (!S.next(0, cur)) return;
    f32x4 acc[2][2][4][2];
#pragma unroll
    for (int a = 0; a < 2; ++a)
#pragma unroll
        for (int b = 0; b < 2; ++b)
#pragma unroll
            for (int m = 0; m < 4; ++m)
#pragma unroll
                for (int n = 0; n < 2; ++n) acc[a][b][m][n] = (f32x4){0.f, 0.f, 0.f, 0.f};
    bf16x8 At[4][2], B0[2][2], B1[2][2];
    const char* cA = (const char*)g.A + (size_t)cur.pm * tstepA; const char* cB = (const char*)g.Bt + (size_t)cur.pn * tstepB;
    S.a_ready(cur);
    if constexpr (SP2) {
        PG8_STAGE(PG8_SB(0, 0), cB, voffB); PG8_STAGE(PG8_SB(0, 1), cB + hstepB, voffB); PG8_STAGE(PG8_SA(0, 0), cA, voffA); PG8_STAGE(PG8_SA(0, 1), cA + hstepA, voffA);
        if (wr == 1) PG8_BAR;
        PG8_WAIT_V(2); PG8_BAR;
        PG8_STAGE(PG8_SB(1, 0), cB + kstep, voffB); PG8_STAGE(PG8_SA(1, 0), cA + kstep, voffA); PG8_STAGE(PG8_SB(1, 1), cB + hstepB + kstep, voffB);
        PG8_WAIT_V(6); PG8_BAR;
    } else {
        PG8_STAGE(PG8_SB(0, 0), cB, voffB); PG8_STAGE(PG8_SA(0, 0), cA, voffA); PG8_STAGE(PG8_SB(0, 1), cB + hstepB, voffB); PG8_STAGE(PG8_SA(0, 1), cA + hstepA, voffA);
        if (wr == 1) PG8_BAR;
        PG8_WAIT_V(4); PG8_BAR;
        PG8_STAGE(PG8_SB(1, 0), cB + kstep, voffB); PG8_STAGE(PG8_SA(1, 0), cA + kstep, voffA); PG8_STAGE(PG8_SB(1, 1), cB + hstepB + kstep, voffB);
        PG8_WAIT_V(6); PG8_BAR;
    }
    for (;;) {
        const bool has_next = S.next(ui + 1, nxt);
        const char* nA = has_next ? (const char*)g.A + (size_t)nxt.pm * tstepA : cA; const char* nB = has_next ? (const char*)g.Bt + (size_t)nxt.pn * tstepB : cB;
        for (int t = 0; t < nt; t += 2) {
            const bool last = (t == nt - 2);
            const char* a1 = cA + (size_t)(t + 1) * kstep;
            const char* a2 = last ? nA : cA + (size_t)(t + 2) * kstep; const char* b2 = last ? nB : cB + (size_t)(t + 2) * kstep;
            const char* a3 = a2 + kstep; const char* b3 = b2 + kstep;
            if (last && has_next) S.a_ready(nxt);
            if constexpr (SP2) {
            PG8_LDB(B0, 0, 0); PG8_LDB(B1, 0, 1); PG8_SCHED; PG8_LDA(At, 0, 0); PG8_STAGE(PG8_SA(1, 1), a1 + hstepA, voffA);
            PG8_WAIT_V(8); PG8_WAIT_L(0); PG8_BAR; PG8_MMA(0, 0, At, B0); PG8_MMA(0, 1, At, B1); PG8_BAR; PG8_SCHED;
            PG8_LDA(At, 0, 1); PG8_STAGE(PG8_SB(0, 0), b2, voffB); PG8_STAGE(PG8_SB(0, 1), b2 + hstepB, voffB); PG8_STAGE(PG8_SA(0, 0), a2, voffA);
            PG8_WAIT_V(8); PG8_WAIT_L(0); PG8_BAR; PG8_MMA(1, 0, At, B0); PG8_MMA(1, 1, At, B1); PG8_BAR; PG8_SCHED;
            PG8_LDB(B0, 1, 0); PG8_LDB(B1, 1, 1); PG8_SCHED; PG8_LDA(At, 1, 0); PG8_STAGE(PG8_SA(0, 1), a2 + hstepA, voffA);
            PG8_WAIT_V(8); PG8_WAIT_L(0); PG8_BAR; PG8_MMA(0, 0, At, B0); PG8_MMA(0, 1, At, B1); PG8_BAR; PG8_SCHED;
            PG8_LDA(At, 1, 1); PG8_STAGE(PG8_SB(1, 0), b3, voffB); PG8_STAGE(PG8_SB(1, 1), b3 + hstepB, voffB); PG8_STAGE(PG8_SA(1, 0), a3, voffA);
            PG8_WAIT_V(8); PG8_WAIT_L(0); PG8_BAR; PG8_MMA(1, 0, At, B0); PG8_MMA(1, 1, At, B1); PG8_BAR; PG8_SCHED;
            } else {
            PG8_LDB(B0, 0, 0); PG8_SCHED; PG8_LDA(At, 0, 0); PG8_STAGE(PG8_SA(1, 1), a1 + hstepA, voffA);
            PG8_WAIT_L(8); PG8_BAR; PG8_WAIT_L(0); PG8_MMA(0, 0, At, B0); PG8_BAR; PG8_SCHED;
            PG8_LDB(B1, 0, 1); PG8_STAGE(PG8_SB(0, 0), b2, voffB);
            PG8_BAR; PG8_WAIT_L(0); PG8_MMA(0, 1, At, B1); PG8_BAR;
            PG8_LDA(At, 0, 1); PG8_STAGE(PG8_SA(0, 0), a2, voffA);
            PG8_BAR; PG8_WAIT_L(0); PG8_MMA(1, 0, At, B0); PG8_BAR; PG8_SCHED;
            PG8_STAGE(PG8_SB(0, 1), b2 + hstepB, voffB);
            PG8_WAIT_V(6); PG8_BAR; PG8_MMA(1, 1, At, B1); PG8_BAR;
            PG8_LDB(B0, 1, 0); PG8_SCHED; PG8_LDA(At, 1, 0); PG8_STAGE(PG8_SA(0, 1), a2 + hstepA, voffA);
            PG8_WAIT_L(8); PG8_BAR; PG8_WAIT_L(0); PG8_MMA(0, 0, At, B0); PG8_BAR; PG8_SCHED;
            PG8_LDB(B1, 1, 1); PG8_STAGE(PG8_SB(1, 0), b3, voffB);
            PG8_BAR; PG8_WAIT_L(0); PG8_MMA(0, 1, At, B1); PG8_BAR;
            PG8_LDA(At, 1, 1); PG8_STAGE(PG8_SA(1, 0), a3, voffA);
            PG8_BAR; PG8_WAIT_L(0); PG8_MMA(1, 0, At, B0); PG8_BAR; PG8_SCHED;
            PG8_STAGE(PG8_SB(1, 1), b3 + hstepB, voffB);
            PG8_WAIT_V(6); PG8_BAR; PG8_MMA(1, 1, At, B1); PG8_BAR;
            }
        }
        if constexpr (ALIGN_EPI) { if (wr == 0) PG8_BAR; }
        if constexpr (!Epi::AFTER_DRAIN) { E(acc, cur, wr, wc, fr, fq); S.done(cur); }
        if (!has_next) break;
#pragma unroll
        for (int a = 0; a < 2; ++a)
#pragma unroll
            for (int b = 0; b < 2; ++b)
#pragma unroll
                for (int m = 0; m < 4; ++m)
#pragma unroll
                    for (int n = 0; n < 2; ++n) acc[a][b][m][n] = (f32x4){0.f, 0.f, 0.f, 0.f};
        cur = nxt; cA = nA; cB = nB; ++ui;
        if constexpr (ALIGN_EPI) { if (wr == 1) PG8_BAR; }
    }
    PG8_WAIT_V(0);
    if constexpr (!ALIGN_EPI) { if (wr == 0) PG8_BAR; }
    PG8_BAR;
    if constexpr (Epi::AFTER_DRAIN) { E.fused(acc, cur, wr, wc, fr, fq, lds, wid, lane); S.done(cur); }
#undef PG8_SA
#undef PG8_SB
#undef PG8_STAGE
#undef PG8_LDA
#undef PG8_LDB
#undef PG8_MMA
#undef PG8_WAIT_V
#undef PG8_WAIT_L
#undef PG8_BAR
#undef PG8_SCHED
}
}
constexpr int M = 8192, D = 2048, FF = 5632, SEQ = 4096, NUP = 2 * FF, D_IN = 10704;
constexpr int PW = 10752;
constexpr int PQ = 0, PK = 512, PV = 1024, PR = 2048;
constexpr int RR = 3072, RK = 4096, RV = 5120;
constexpr int GG = 6144, GR = 8192;
constexpr int SM = 10240;
constexpr int NLORA = 3072, KLORA = 512;
constexpr size_t MiB = 1u << 20;
constexpr size_t WS_WUP = 1 * MiB, WS_WDN = 45 * MiB, WS_WIN = 67 * MiB, WS_WBR1 = 109 * MiB, WS_WBR2 = 113 * MiB, WS_WOUT = 117 * MiB, WS_WLORA = 125 * MiB;
constexpr size_t WS_H = 128 * MiB, WS_X1 = 160 * MiB, WS_P = 224 * MiB, WS_LORA = 392 * MiB, WS_END = 440 * MiB;
constexpr size_t WS_ALORA = WS_H, WS_GTOT = WS_H + 8 * MiB, WS_OGLA = WS_H + 16 * MiB;
constexpr size_t WS_Y = WS_WIN;
constexpr size_t WS_ACT = WS_P;
constexpr size_t OUT_STATE = 0, OUT_ORW = 0, OUT_T = 16 * MiB;
constexpr size_t WS_SS1 = 0, WS_SS2 = 65536, WS_SS3 = 98304;
constexpr size_t WS_ORW = 1 * MiB, WS_T = 17 * MiB, WS_WDN2 = 49 * MiB;
constexpr int LDS_BYTES = 147456;

#define LAS __attribute__((address_space(3)))
typedef unsigned short bf16;
typedef unsigned v4u __attribute__((ext_vector_type(4)));
typedef unsigned v2u __attribute__((ext_vector_type(2)));
typedef float f32x4 __attribute__((ext_vector_type(4)));
typedef float f32x2 __attribute__((ext_vector_type(2)));
typedef short bf16x8 __attribute__((ext_vector_type(8)));
#define LDS_WAIT() asm volatile("s_waitcnt lgkmcnt(0)" ::: "memory")
__device__ __forceinline__ unsigned f2bf(float f) { unsigned u = __builtin_bit_cast(unsigned, f); return (u + 0x7fffu + ((u >> 16) & 1u)) >> 16; }
__device__ __forceinline__ unsigned pk2(float lo, float hi) { return f2bf(lo) | (f2bf(hi) << 16); }
__device__ __forceinline__ float bflo(unsigned u) { return __uint_as_float(u << 16); }
__device__ __forceinline__ float bfhi(unsigned u) { return __uint_as_float(u & 0xffff0000u); }
__device__ __forceinline__ float bf1(bf16 u) { return __uint_as_float((unsigned)u << 16); }
__device__ __forceinline__ float sigmoidf_(float x) { return __builtin_amdgcn_rcpf(1.0f + __builtin_amdgcn_exp2f(-1.4426950408889634f * x)); }
__device__ __forceinline__ float wave_sum(float v) {
#pragma unroll
    for (int o = 1; o < 64; o <<= 1) v += __shfl_xor(v, o);
    return v;
}
template <int CTRL> __device__ __forceinline__ float dppf(float v) { return __builtin_bit_cast(float, __builtin_amdgcn_update_dpp(0, __builtin_bit_cast(int, v), CTRL, 0xF, 0xF, true)); }
__device__ __forceinline__ float allred8(float v) { v += dppf<0xB1>(v); v += dppf<0x4E>(v); v += dppf<0x141>(v); return v; }
__device__ __forceinline__ float allred16(float v) { v = allred8(v); v += dppf<0x140>(v); return v; }

#define XB_TMO      128
#define XB_XCNT(j)  (256  + 64 * (j))
#define XB_XSUB(j)  (1280 + 64 * (j))
#define XB_XGEN(j)  (2304 + 64 * (j))
#define XB_TOP      3328
#define XB_TOPGEN   3392
#define XCD_BAR_WORDS 3456
#define XB_SPIN_CAP (1u << 18)

__device__ __forceinline__ unsigned xb_ld(unsigned* p)              { return __hip_atomic_load(p, __ATOMIC_RELAXED, __HIP_MEMORY_SCOPE_AGENT); }
__device__ __forceinline__ unsigned xb_add(unsigned* p, unsigned v) { return __hip_atomic_fetch_add(p, v, __ATOMIC_RELAXED, __HIP_MEMORY_SCOPE_AGENT); }
__device__ __forceinline__ unsigned xb_xcc_id() { return (unsigned)__builtin_amdgcn_s_getreg((3 << 11) | 20) & 0xFu; }
#define XB_SPIN(cond, bar) do { unsigned _sp = 0; while (cond) { __builtin_amdgcn_s_sleep(1); \
    if ((++_sp & 255u) == 0u) { if (xb_ld(&(bar)[XB_TMO])) break; if (_sp > XB_SPIN_CAP) { atomicAdd(&(bar)[XB_TMO], 1u); break; } } } } while (0)

struct XcdBarrier {
    unsigned* bar; unsigned x;
    volatile LAS unsigned* st;
};

__device__ __forceinline__ XcdBarrier xcd_barrier_post(unsigned* bar, volatile LAS unsigned* st) {
    XcdBarrier b; b.bar = bar; b.x = xb_xcc_id(); b.st = st;
    if (threadIdx.x == 0) (void)xb_add(&bar[XB_XCNT(b.x)], 1u);
    return b;
}
__device__ __forceinline__ void xcd_barrier_complete(unsigned* bar, unsigned x, unsigned& nloc, unsigned& nx) {
    const unsigned G = gridDim.x * gridDim.y * gridDim.z;
    unsigned sum, cnt, mine, sp = 0u;
    for (;;) {
        sum = 0u; cnt = 0u; mine = 0u;
#pragma unroll
        for (unsigned j = 0; j < 16; ++j) { const unsigned c = xb_ld(&bar[XB_XCNT(j)]); sum += c; cnt += (c > 0u) ? 1u : 0u; mine = (j == x) ? c : mine; }
        if (sum == G) break;
        __builtin_amdgcn_s_sleep(1);
        if ((++sp & 255u) == 0u) { if (xb_ld(&bar[XB_TMO])) break; if (sp > XB_SPIN_CAP) { atomicAdd(&bar[XB_TMO], 1u); break; } }
    }
    nloc = mine > 0u ? mine : 1u; nx = cnt > 0u ? cnt : 1u;
}

__device__ __forceinline__ void xcd_barrier(const XcdBarrier& b) {
    asm volatile("s_waitcnt vmcnt(0)" ::: "memory");
    __syncthreads();
    if (threadIdx.x == 0) {
        unsigned* bar = b.bar;
        __builtin_amdgcn_s_waitcnt(0);
        unsigned nloc = b.st[0], nx = b.st[1];
        if (nloc == 0u) { xcd_barrier_complete(bar, b.x, nloc, nx); b.st[0] = nloc; b.st[1] = nx; }
        const unsigned old = xb_add(&bar[XB_XSUB(b.x)], 1u);
        const unsigned gen = old / nloc;
        if (old + 1u == (gen + 1u) * nloc) {
            __builtin_amdgcn_fence(__ATOMIC_RELEASE, "agent");
            asm volatile("s_waitcnt vmcnt(0)" ::: "memory");
            const unsigned og = xb_add(&bar[XB_TOP], 1u);
            const unsigned tg = og / nx;
            if (og + 1u == (tg + 1u) * nx) xb_add(&bar[XB_TOPGEN], 1u);
            else XB_SPIN(xb_ld(&bar[XB_TOPGEN]) == tg, bar);
            __builtin_amdgcn_fence(__ATOMIC_ACQUIRE, "agent");
            xb_add(&bar[XB_XGEN(b.x)], 1u);
            asm volatile("s_waitcnt vmcnt(0)" ::: "memory");
        } else {
            XB_SPIN(xb_ld(&bar[XB_XGEN(b.x)]) == gen, bar);
            __builtin_amdgcn_fence(__ATOMIC_ACQUIRE, "agent");
            asm volatile("s_waitcnt vmcnt(0)" ::: "memory");
        }
    }
    __syncthreads();
}

constexpr size_t WS_BAR = 262144;
struct Frame {
    LAS unsigned char* lds;
    int tid, lane, wave, gw, NGW, G;
    const float* in[29]; float* out; unsigned char* ws;
};
enum { I_X = 0, I_N1, I_WG1, I_WU1, I_WD1, I_NMIX, I_WIN, I_GLA_WA2, I_GLA_BA, I_GLA_GN, I_MU, I_W0, I_WW2, I_A0, I_WA2, I_WG2, I_KK, I_KA, I_RK, I_LNW, I_LNB, I_GATEB, I_WBR, I_WOUT, I_N2, I_WG2F, I_WU2F, I_WD2F, I_NF };

template <class F> __device__ __forceinline__ void tr_item(const F& srcf, int ldw, bf16* WT, int Kd, int kb, int nb, LAS float* scr, int lane) {
    const int k0 = 64 * kb, n0 = 32 * nb;
    const int kr = lane >> 3, n4 = lane & 7;
    const float* p = srcf(n0 + 4 * n4);
#pragma unroll
    for (int i = 0; i < 8; ++i) { const int kk = 8 * i + kr; const f32x4 v = p ? *(const f32x4*)(p + (size_t)(k0 + kk) * ldw) : (f32x4){0.f, 0.f, 0.f, 0.f};
        LAS float* d = scr + kk * 33 + 4 * n4; d[0] = v.x; d[1] = v.y; d[2] = v.z; d[3] = v.w; }
    LDS_WAIT(); asm volatile("" ::: "memory");
    const int c = lane & 7;
#pragma unroll
    for (int j = 0; j < 4; ++j) { const int n = (lane >> 3) + 8 * j; const LAS float* s = scr + (8 * c) * 33 + n;
        v4u o; o.x = pk2(s[0 * 33], s[1 * 33]); o.y = pk2(s[2 * 33], s[3 * 33]); o.z = pk2(s[4 * 33], s[5 * 33]); o.w = pk2(s[6 * 33], s[7 * 33]);
        *(v4u*)(WT + (size_t)(n0 + n) * Kd + k0 + 8 * c) = o; }
    LDS_WAIT(); asm volatile("" ::: "memory");
}
template <class F> __device__ __forceinline__ void tr_job(const Frame& F_, const F& srcf, int ldw, bf16* WT, int Ksrc, int Ndest, int w0, int nw) {
    LAS float* scr = (LAS float*)(F_.lds + F_.wave * 8448);
    const int nblk = Ndest / 32, items = (Ksrc / 64) * nblk;
    for (int it = w0; it < items; it += nw) tr_item(srcf, ldw, WT, Ksrc, it / nblk, it % nblk, scr, F_.lane);
}
struct SrcUp { const float* wg; const float* wu; __device__ __forceinline__ const float* operator()(int n) const { const int t = n >> 8, w = n & 255; return (w < 128) ? wg + 128 * t + w : wu + 128 * t + (w - 128); } };
struct SrcPlain { const float* w; __device__ __forceinline__ const float* operator()(int n) const { return w + n; } };
struct SrcWin { const float* w; __device__ __forceinline__ const float* operator()(int c) const {
    int s;
    if (c < 3072) s = c; else if (c < 6144) s = c + 16; else if (c < 10240) s = c + 464;
    else { const int j = c - 10240; if (j < 16) s = 3072 + j; else if (j < 32) s = -1; else if (j < 128) s = 6160 + (j - 32); else if (j < 224) s = 6256 + (j - 128); else if (j < 256) s = -1; else s = 6352 + (j - 256); }
    return s < 0 ? nullptr : w + s; } };
__device__ __forceinline__ void convert_ffn_up(const Frame& F, int l, bf16* dst, int w0, int nw) { tr_job(F, SrcUp{F.in[l ? I_WG2F : I_WG1], F.in[l ? I_WU2F : I_WU1]}, FF, dst, D, NUP, w0, nw); }
__device__ __forceinline__ void convert_ffn_dn(const Frame& F, int l, bf16* dst, int w0, int nw) { tr_job(F, SrcPlain{F.in[l ? I_WD2F : I_WD1]}, D, dst, FF, D, w0, nw); }
__device__ __forceinline__ void convert_ffn(const Frame& F, int l, int w0, int nw) { convert_ffn_up(F, l, (bf16*)(F.ws + WS_WUP), w0, nw); convert_ffn_dn(F, l, (bf16*)(F.ws + WS_WDN), w0, nw); }
__device__ __forceinline__ void norm_rows_bf16(const Frame& F, const float* X, const float* g, bf16* H) {
    for (int m = F.gw; m < M; m += 2 * F.NGW) {
        const int m2 = (m + F.NGW < M) ? m + F.NGW : m;
        const f32x4* xa = (const f32x4*)(X + (size_t)m * D) + F.lane; const f32x4* xb = (const f32x4*)(X + (size_t)m2 * D) + F.lane; f32x4 va[8], vb[8]; float sa = 0.f, sb = 0.f;
#pragma unroll
        for (int j = 0; j < 8; ++j) { va[j] = xa[64 * j]; vb[j] = xb[64 * j]; }
#pragma unroll
        for (int j = 0; j < 8; ++j) { sa += (va[j].x * va[j].x + va[j].y * va[j].y) + (va[j].z * va[j].z + va[j].w * va[j].w); sb += (vb[j].x * vb[j].x + vb[j].y * vb[j].y) + (vb[j].z * vb[j].z + vb[j].w * vb[j].w); }
        const float ra = rsqrtf(wave_sum(sa) * (1.0f / D) + 1e-6f), rb = rsqrtf(wave_sum(sb) * (1.0f / D) + 1e-6f);
        v2u* oa = (v2u*)(H + (size_t)m * D) + F.lane; v2u* ob = (v2u*)(H + (size_t)m2 * D) + F.lane;
#pragma unroll
        for (int j = 0; j < 8; ++j) { const f32x4 gv = ((const f32x4*)g)[F.lane + 64 * j];
            v2u o; o.x = pk2(va[j].x * ra * gv.x, va[j].y * ra * gv.y); o.y = pk2(va[j].z * ra * gv.z, va[j].w * ra * gv.w); oa[64 * j] = o;
            o.x = pk2(vb[j].x * rb * gv.x, vb[j].y * rb * gv.y); o.y = pk2(vb[j].z * rb * gv.z, vb[j].w * rb * gv.w); ob[64 * j] = o; }
    }
}
__device__ __forceinline__ void final_norm(const Frame& F, float* X, const float* g) {
    for (int m = F.gw; m < M; m += 2 * F.NGW) {
        const int m2 = (m + F.NGW < M) ? m + F.NGW : m;
        f32x4* xa = (f32x4*)(X + (size_t)m * D) + F.lane; f32x4* xb = (f32x4*)(X + (size_t)m2 * D) + F.lane; f32x4 va[8], vb[8]; float sa = 0.f, sb = 0.f;
#pragma unroll
        for (int j = 0; j < 8; ++j) { va[j] = xa[64 * j]; vb[j] = xb[64 * j]; }
#pragma unroll
        for (int j = 0; j < 8; ++j) { sa += (va[j].x * va[j].x + va[j].y * va[j].y) + (va[j].z * va[j].z + va[j].w * va[j].w); sb += (vb[j].x * vb[j].x + vb[j].y * vb[j].y) + (vb[j].z * vb[j].z + vb[j].w * vb[j].w); }
        const float ra = rsqrtf(wave_sum(sa) * (1.0f / D) + 1e-6f), rb = rsqrtf(wave_sum(sb) * (1.0f / D) + 1e-6f);
#pragma unroll
        for (int j = 0; j < 8; ++j) { const f32x4 gv = ((const f32x4*)g)[F.lane + 64 * j]; xa[64 * j] = va[j] * ra * gv; if (m2 != m) xb[64 * j] = vb[j] * rb * gv; }
    }
}
__device__ __forceinline__ void final_scale(const Frame& F, const bf16* XB, const float* ss, float* out) {
    for (int m = F.gw; m < M; m += F.NGW) {
        const float rstd = rsqrtf(ss[m] * (1.0f / D) + 1e-6f);
        const v4u* xr = (const v4u*)(XB + (size_t)m * D) + F.lane; f32x4* o = (f32x4*)(out + (size_t)m * D) + 2 * F.lane; v4u v[4];
#pragma unroll
        for (int j = 0; j < 4; ++j) v[j] = xr[64 * j];
#pragma unroll
        for (int j = 0; j < 4; ++j) { o[128 * j] = (f32x4){bflo(v[j].x), bfhi(v[j].x), bflo(v[j].y), bfhi(v[j].y)} * rstd; o[128 * j + 1] = (f32x4){bflo(v[j].z), bfhi(v[j].z), bflo(v[j].w), bfhi(v[j].w)} * rstd; }
    }
}
__device__ __forceinline__ void p_prologue(const Frame& F) {
    convert_ffn_up(F, 0, (bf16*)(F.ws + WS_WUP), F.gw, F.NGW);
    { unsigned* WL = (unsigned*)(F.ws + WS_WLORA); const int gt = F.gw * 64 + F.lane, GT = F.NGW * 64;
      for (int i = gt; i < NLORA * 128; i += GT) { const int n = i >> 7, k = (i & 127) * 2; float v0 = 0.f, v1 = 0.f;
          if (n < 1024) { if (k >= 32 && k < 128) { v0 = F.in[I_WW2][(size_t)(k - 32) * 1024 + n]; v1 = F.in[I_WW2][(size_t)(k - 31) * 1024 + n]; } }
          else if (n < 2048) { if (k >= 128 && k < 224) { v0 = F.in[I_WA2][(size_t)(k - 128) * 1024 + n - 1024]; v1 = F.in[I_WA2][(size_t)(k - 127) * 1024 + n - 1024]; } }
          else { v0 = F.in[I_WG2][(size_t)k * 1024 + n - 2048]; v1 = F.in[I_WG2][(size_t)(k + 1) * 1024 + n - 2048]; }
          WL[i] = pk2(v0, v1); } }
    norm_rows_bf16(F, F.in[I_X], F.in[I_N1], (bf16*)(F.ws + WS_H));
    { float* z = (float*)(F.ws + WS_SS1); for (int i = F.gw * 64 + F.lane; i < 2 * 16384; i += F.NGW * 64) z[i] = 0.f; }
}
__device__ __forceinline__ void p_lora_a(const Frame& F) {
    const bf16* P = (const bf16*)(F.ws + WS_P); bf16* A = (bf16*)(F.ws + WS_ALORA); const float* mu = F.in[I_MU];
    const int j0 = 8 * F.lane;
    int kind, mi;
    if (j0 < 32) { kind = 0; mi = 0; } else if (j0 < 128) { kind = 1; mi = 3072 + j0 - 32; } else if (j0 < 224) { kind = 2; mi = 3168 + j0 - 128; } else if (j0 < 256) { kind = 0; mi = 0; } else { kind = 3; mi = 3264 + j0 - 256; }
    float muv[8];
#pragma unroll
    for (int j = 0; j < 8; ++j) muv[j] = kind ? mu[mi + j] : 0.f;
    for (int m = F.gw; m < M; m += F.NGW) {
        const bool first = (m % SEQ) == 0;
        const v4u c = *(const v4u*)(P + (size_t)m * PW + SM + j0);
        v4u p = *(const v4u*)(P + (size_t)(first ? m : m - 1) * PW + SM + j0);
        if (first) p = (v4u){0u, 0u, 0u, 0u};
        float cv[8] = {bflo(c.x), bfhi(c.x), bflo(c.y), bfhi(c.y), bflo(c.z), bfhi(c.z), bflo(c.w), bfhi(c.w)};
        float pv[8] = {bflo(p.x), bfhi(p.x), bflo(p.y), bfhi(p.y), bflo(p.z), bfhi(p.z), bflo(p.w), bfhi(p.w)};
        float o[8];
#pragma unroll
        for (int j = 0; j < 8; ++j) { const float s = cv[j] + muv[j] * (pv[j] - cv[j]);
            o[j] = kind == 0 ? 0.f : kind == 1 ? (1.0f - 2.0f * __builtin_amdgcn_rcpf(1.0f + __builtin_amdgcn_exp2f(2.885390081777927f * s))) : kind == 2 ? s : sigmoidf_(s); }
        v4u w; w.x = pk2(o[0], o[1]); w.y = pk2(o[2], o[3]); w.z = pk2(o[4], o[5]); w.w = pk2(o[6], o[7]);
        *(v4u*)(A + (j0 < 256 ? (size_t)m * 256 + j0 : (size_t)M * 256 + (size_t)m * 256 + (j0 - 256))) = w;
    }
}
__device__ __forceinline__ float log_sigmoid_(float z) { return fminf(z, 0.f) - __logf(1.0f + __expf(-fabsf(z))); }
__device__ __forceinline__ void gla_u_unit(const Frame& F, int unit) {
    const int b = unit >> 8, n = (unit >> 2) & 63, h = unit & 3, tid = F.tid;
    const bf16* P = (const bf16*)(F.ws + WS_P); const size_t row0 = (size_t)b * SEQ + (size_t)n * 64;
    LAS float* adS = (LAS float*)F.lds;
    LAS float* qtot = (LAS float*)(F.lds + 4096);
    LAS bf16* kdT = (LAS bf16*)(F.lds + 8192);
    LAS bf16* vT = (LAS bf16*)(F.lds + 8192 + 18432);
    if (tid < 128) { const int c = tid >> 1, hf = tid & 1; const v4u a = *(const v4u*)(P + (row0 + c) * PW + SM + 8 * hf);
        LAS float* d = adS + c * 16 + 8 * hf; d[0] = bflo(a.x); d[1] = bfhi(a.x); d[2] = bflo(a.y); d[3] = bfhi(a.y); d[4] = bflo(a.z); d[5] = bfhi(a.z); d[6] = bflo(a.w); d[7] = bfhi(a.w); }
    const int k = tid & 127, q = tid >> 7;
    float wa[16];
#pragma unroll
    for (int j = 0; j < 16; ++j) wa[j] = F.in[I_GLA_WA2][j * 512 + h * 128 + k];
    const float ba = F.in[I_GLA_BA][h * 128 + k];
#pragma unroll
    for (int i = 0; i < 4; ++i) { const int idx = tid + 512 * i, c = idx & 63, v8 = idx >> 6; const v4u vv = *(const v4u*)(P + (row0 + c) * PW + PV + h * 256 + 8 * v8);
        LAS bf16* d = vT + (8 * v8) * 72 + c; d[0] = (bf16)(vv.x & 0xffff); d[72] = (bf16)(vv.x >> 16); d[144] = (bf16)(vv.y & 0xffff); d[216] = (bf16)(vv.y >> 16);
        d[288] = (bf16)(vv.z & 0xffff); d[360] = (bf16)(vv.z >> 16); d[432] = (bf16)(vv.w & 0xffff); d[504] = (bf16)(vv.w >> 16); }
    __syncthreads();
    float cum[16]; float run = 0.f;
#pragma unroll
    for (int ci = 0; ci < 16; ++ci) { const LAS f32x4* ar = (const LAS f32x4*)(adS + (16 * q + ci) * 16); float z = ba;
#pragma unroll
        for (int j4 = 0; j4 < 4; ++j4) { const f32x4 a = ar[j4]; z += a.x * wa[4 * j4] + a.y * wa[4 * j4 + 1] + a.z * wa[4 * j4 + 2] + a.w * wa[4 * j4 + 3]; }
        run += log_sigmoid_(z) * (1.0f / 16.0f); cum[ci] = run; }
    qtot[q * 128 + k] = run;
    __syncthreads();
    float off = 0.f, tot = 0.f;
#pragma unroll
    for (int qq = 0; qq < 4; ++qq) { const float t = qtot[qq * 128 + k]; tot += t; if (qq < q) off += t; }
#pragma unroll
    for (int ci = 0; ci < 16; ++ci) { const int c = 16 * q + ci; const float kf = bf1(P[(row0 + c) * PW + PK + h * 128 + k]);
        kdT[k * 72 + c] = (bf16)f2bf(kf * __expf(tot - (off + cum[ci]))); }
    if (q == 0) ((float*)(F.ws + WS_GTOT))[(size_t)unit * 128 + k] = tot;
    __syncthreads();
    const int w = F.wave, fr = F.lane & 15, fq = F.lane >> 4;
    f32x4 acc[16];
#pragma unroll
    for (int i = 0; i < 16; ++i) acc[i] = (f32x4){0.f, 0.f, 0.f, 0.f};
#pragma unroll
    for (int ks = 0; ks < 2; ++ks) { const bf16x8 a = *(const LAS bf16x8*)(kdT + (16 * w + fr) * 72 + fq * 8 + 32 * ks);
#pragma unroll
        for (int nt = 0; nt < 16; ++nt) { const bf16x8 bb = *(const LAS bf16x8*)(vT + (16 * nt + fr) * 72 + fq * 8 + 32 * ks); acc[nt] = __builtin_amdgcn_mfma_f32_16x16x32_bf16(a, bb, acc[nt], 0, 0, 0); } }
    float* U = F.out + OUT_STATE / 4 + (size_t)unit * 128 * 256;
    __syncthreads();
    LAS float* uS = (LAS float*)F.lds;
#pragma unroll
    for (int nt = 0; nt < 16; ++nt)
#pragma unroll
        for (int j = 0; j < 4; ++j) uS[(16 * w + 4 * fq + j) * 260 + 16 * nt + fr] = acc[nt][j];
    __syncthreads();
#pragma unroll 4
    for (int i = 0; i < 16; ++i) { const int idx = tid + 512 * i, row = idx >> 6, c4 = idx & 63; *(f32x4*)(U + (size_t)row * 256 + 4 * c4) = *(const LAS f32x4*)(uS + row * 260 + 4 * c4); }
    __syncthreads();
}
__device__ __forceinline__ void gla_chain(const Frame& F) {
    const int gt = F.gw * 64 + F.lane;
    const float* GT = (const float*)(F.ws + WS_GTOT);
    for (int e = gt; e < 2 * 4 * 128 * 128; e += F.NGW * 64) {
        const int v2 = e & 127, k = (e >> 7) & 127, h = (e >> 14) & 3, b = e >> 16;
        f32x2 s = (f32x2){0.f, 0.f};
        for (int n0 = 0; n0 < 64; n0 += 8) {
            f32x2 u[8]; float d[8];
#pragma unroll
            for (int i = 0; i < 8; ++i) { const size_t un = ((size_t)(b * 64 + n0 + i) * 4 + h); u[i] = *(const f32x2*)(F.out + OUT_STATE / 4 + (un * 128 + k) * 256 + 2 * v2); d[i] = GT[un * 128 + k]; }
#pragma unroll
            for (int i = 0; i < 8; ++i) { const size_t un = ((size_t)(b * 64 + n0 + i) * 4 + h); const float dd = __expf(d[i]); s = s * dd + u[i]; *(f32x2*)(F.out + OUT_STATE / 4 + (un * 128 + k) * 256 + 2 * v2) = s; }
        }
    }
}
__device__ __forceinline__ void gla_o_unit(const Frame& F, int unit) {
    const int b = unit >> 8, n = (unit >> 2) & 63, h = unit & 3, tid = F.tid;
    const bf16* P = (const bf16*)(F.ws + WS_P); const size_t row0 = (size_t)b * SEQ + (size_t)n * 64;
    LAS bf16* sT = (LAS bf16*)F.lds;
    LAS bf16* qS = (LAS bf16*)(F.lds + 69632);
    LAS float* ssb = (LAS float*)(F.lds + 69632 + 17408);
    const float* ST = F.out + OUT_STATE / 4 + (size_t)unit * 128 * 256;
#pragma unroll 4
    for (int i = 0; i < 16; ++i) { const int idx = tid + 512 * i, rest = idx >> 6, k = (rest & 7) * 16 + (idx & 15), v4 = (rest >> 3) * 4 + ((idx >> 4) & 3); const f32x4 s = *(const f32x4*)(ST + (size_t)k * 256 + 4 * v4);
        LAS bf16* d = sT + (4 * v4) * 136 + k; d[0] = (bf16)f2bf(s.x); d[136] = (bf16)f2bf(s.y); d[272] = (bf16)f2bf(s.z); d[408] = (bf16)f2bf(s.w); }
#pragma unroll
    for (int i = 0; i < 2; ++i) { const int idx = tid + 512 * i, c = idx >> 4, k8 = idx & 15; *(LAS v4u*)(qS + c * 136 + 8 * k8) = *(const v4u*)(P + (row0 + c) * PW + PQ + h * 128 + 8 * k8); }
    __syncthreads();
    const int w = F.wave, fr = F.lane & 15, fq = F.lane >> 4;
    f32x4 acc[4][2];
#pragma unroll
    for (int mt = 0; mt < 4; ++mt) { acc[mt][0] = (f32x4){0.f, 0.f, 0.f, 0.f}; acc[mt][1] = (f32x4){0.f, 0.f, 0.f, 0.f}; }
#pragma unroll
    for (int ks = 0; ks < 4; ++ks) {
        bf16x8 bq[2];
#pragma unroll
        for (int nt = 0; nt < 2; ++nt) bq[nt] = *(const LAS bf16x8*)(sT + (32 * w + 16 * nt + fr) * 136 + fq * 8 + 32 * ks);
#pragma unroll
        for (int mt = 0; mt < 4; ++mt) { const bf16x8 a = *(const LAS bf16x8*)(qS + (16 * mt + fr) * 136 + fq * 8 + 32 * ks);
            acc[mt][0] = __builtin_amdgcn_mfma_f32_16x16x32_bf16(a, bq[0], acc[mt][0], 0, 0, 0); acc[mt][1] = __builtin_amdgcn_mfma_f32_16x16x32_bf16(a, bq[1], acc[mt][1], 0, 0, 0); }
    }
    const float sc = 0.08838834764831845f;
    __syncthreads();
    LAS float* oS = (LAS float*)F.lds;
#pragma unroll
    for (int mt = 0; mt < 4; ++mt)
#pragma unroll
        for (int j = 0; j < 4; ++j) { acc[mt][0][j] *= sc; acc[mt][1][j] *= sc; float ss = acc[mt][0][j] * acc[mt][0][j] + acc[mt][1][j] * acc[mt][1][j]; ss = allred16(ss);
            const int c = 16 * mt + 4 * fq + j; oS[c * 260 + 32 * w + fr] = acc[mt][0][j]; oS[c * 260 + 32 * w + 16 + fr] = acc[mt][1][j];
            if (fr == 0) ssb[w * 64 + c] = ss; }
    __syncthreads();
    const float* gn = F.in[I_GLA_GN]; bf16* OG = (bf16*)(F.ws + WS_OGLA);
    { const int c = tid >> 3, seg = tid & 7; float ss = 0.f;
#pragma unroll
      for (int ww = 0; ww < 8; ++ww) ss += ssb[ww * 64 + c];
      const float rstd = rsqrtf(ss * (1.0f / 256.0f) + 1e-6f);
      v4u rr[4];
#pragma unroll
      for (int i = 0; i < 4; ++i) rr[i] = *(const v4u*)(P + (row0 + c) * PW + PR + h * 256 + 64 * i + 8 * seg);
#pragma unroll
      for (int i = 0; i < 4; ++i) { const int v0 = 64 * i + 8 * seg; const f32x4 o0 = *(const LAS f32x4*)(oS + c * 260 + v0), o1 = *(const LAS f32x4*)(oS + c * 260 + v0 + 4);
          const f32x4 g0 = *(const f32x4*)(gn + v0), g1 = *(const f32x4*)(gn + v0 + 4);
          const float r[8] = {bflo(rr[i].x), bfhi(rr[i].x), bflo(rr[i].y), bfhi(rr[i].y), bflo(rr[i].z), bfhi(rr[i].z), bflo(rr[i].w), bfhi(rr[i].w)};
          float o[8] = {o0.x * g0.x, o0.y * g0.y, o0.z * g0.z, o0.w * g0.w, o1.x * g1.x, o1.y * g1.y, o1.z * g1.z, o1.w * g1.w};
#pragma unroll
          for (int e = 0; e < 8; ++e) o[e] *= rstd * (r[e] * sigmoidf_(r[e]));
          v4u wv; wv.x = pk2(o[0], o[1]); wv.y = pk2(o[2], o[3]); wv.z = pk2(o[4], o[5]); wv.w = pk2(o[6], o[7]);
          *(v4u*)(OG + (row0 + c) * 1024 + h * 256 + v0) = wv; } }
    __syncthreads();
}
constexpr int TC = 32, SBUF_F = 5 * TC * 64 + TC * 16;
#define LDS_BARRIER() do { asm volatile("s_waitcnt lgkmcnt(0)" ::: "memory"); __builtin_amdgcn_s_barrier(); asm volatile("" ::: "memory"); } while (0)
__device__ __forceinline__ void rwkv_scan_block(const Frame& F, int id) {
    const int b = id >> 6, h = (id >> 2) & 15, rg = id & 3, tid = F.tid;
    const bf16* P = (const bf16*)(F.ws + WS_P); const bf16* LO = (const bf16*)(F.ws + WS_LORA);
    LAS float* lds = (LAS float*)F.lds;
    const bool prod = tid >= 256;
    const int p = tid - 256, tt = (p >> 3) & 31, c8 = p & 7;
    float mur[8], muk[8], kkc[8], kac[8], muv[8];
    if (prod) {
#pragma unroll
        for (int j = 0; j < 8; ++j) { const int ch = h * 64 + 8 * c8 + j; mur[j] = F.in[I_MU][ch]; muk[j] = F.in[I_MU][1024 + ch]; kkc[j] = F.in[I_KK][ch]; kac[j] = F.in[I_KA][ch];
            muv[j] = F.in[I_MU][2048 + h * 64 + 16 * rg + 8 * (c8 & 1) + j]; }
    }
    v4u rc, rp, kc, kp, wv, av, vc, vp;
#define SCAN_ISSUE(c) do { const int t_ = (c) * TC + tt; const size_t row_ = (size_t)b * SEQ + t_; const size_t prow_ = t_ ? row_ - 1 : row_; \
        rc = *(const v4u*)(P + row_ * PW + RR + h * 64 + 8 * c8); rp = *(const v4u*)(P + prow_ * PW + RR + h * 64 + 8 * c8); \
        kc = *(const v4u*)(P + row_ * PW + RK + h * 64 + 8 * c8); kp = *(const v4u*)(P + prow_ * PW + RK + h * 64 + 8 * c8); \
        vc = *(const v4u*)(P + row_ * PW + RV + h * 64 + 16 * rg + 8 * (c8 & 1)); vp = *(const v4u*)(P + prow_ * PW + RV + h * 64 + 16 * rg + 8 * (c8 & 1)); \
        wv = *(const v4u*)(LO + row_ * NLORA + h * 64 + 8 * c8); av = *(const v4u*)(LO + row_ * NLORA + 1024 + h * 64 + 8 * c8); } while (0)
#define SCAN_FILL(c, bufp) do { const float pz_ = ((c) * TC + tt) ? 1.f : 0.f; LAS float* B_ = (bufp); \
        const unsigned rcw[4] = {rc.x, rc.y, rc.z, rc.w}, rpw[4] = {rp.x, rp.y, rp.z, rp.w}, kcw[4] = {kc.x, kc.y, kc.z, kc.w}, kpw[4] = {kp.x, kp.y, kp.z, kp.w}; \
        const unsigned wvw[4] = {wv.x, wv.y, wv.z, wv.w}, avw[4] = {av.x, av.y, av.z, av.w}, vcw[4] = {vc.x, vc.y, vc.z, vc.w}, vpw[4] = {vp.x, vp.y, vp.z, vp.w}; \
        float rs_[8], ks_[8], kr_[8], a_[8], w_[8], vs_[8]; float ss_ = 0.f; \
        _Pragma("unroll") for (int j = 0; j < 8; ++j) { const unsigned rcu = rcw[j >> 1], rpu = rpw[j >> 1], kcu = kcw[j >> 1], kpu = kpw[j >> 1], wu_ = wvw[j >> 1], au_ = avw[j >> 1], vcu = vcw[j >> 1], vpu = vpw[j >> 1]; \
            const float rcf = (j & 1) ? bfhi(rcu) : bflo(rcu), rpf = ((j & 1) ? bfhi(rpu) : bflo(rpu)) * pz_, kcf = (j & 1) ? bfhi(kcu) : bflo(kcu), kpf = ((j & 1) ? bfhi(kpu) : bflo(kpu)) * pz_; \
            const float vcf = (j & 1) ? bfhi(vcu) : bflo(vcu), vpf = ((j & 1) ? bfhi(vpu) : bflo(vpu)) * pz_; \
            rs_[j] = rcf + mur[j] * (rpf - rcf); ks_[j] = kcf + muk[j] * (kpf - kcf); vs_[j] = vcf + muv[j] * (vpf - vcf); kr_[j] = ks_[j] * kkc[j]; ss_ += kr_[j] * kr_[j]; \
            a_[j] = (j & 1) ? bfhi(au_) : bflo(au_); w_[j] = 1.0f - ((j & 1) ? bfhi(wu_) : bflo(wu_)); } \
        ss_ = allred8(ss_); const float inv_ = 1.0f / fmaxf(sqrtf(ss_), 1e-12f); \
        float km_[8], kk_[8], bb_[8]; \
        _Pragma("unroll") for (int j = 0; j < 8; ++j) { kk_[j] = kr_[j] * inv_; km_[j] = ks_[j] * (1.0f + (a_[j] - 1.0f) * kac[j]); bb_[j] = kk_[j] * a_[j]; } \
        const int o_ = tt * 64 + 8 * c8; \
        *(LAS f32x4*)(B_ + o_) = (f32x4){rs_[0], rs_[1], rs_[2], rs_[3]}; *(LAS f32x4*)(B_ + o_ + 4) = (f32x4){rs_[4], rs_[5], rs_[6], rs_[7]}; \
        *(LAS f32x4*)(B_ + TC * 64 + o_) = (f32x4){w_[0], w_[1], w_[2], w_[3]}; *(LAS f32x4*)(B_ + TC * 64 + o_ + 4) = (f32x4){w_[4], w_[5], w_[6], w_[7]}; \
        *(LAS f32x4*)(B_ + 2 * TC * 64 + o_) = (f32x4){km_[0], km_[1], km_[2], km_[3]}; *(LAS f32x4*)(B_ + 2 * TC * 64 + o_ + 4) = (f32x4){km_[4], km_[5], km_[6], km_[7]}; \
        *(LAS f32x4*)(B_ + 3 * TC * 64 + o_) = (f32x4){kk_[0], kk_[1], kk_[2], kk_[3]}; *(LAS f32x4*)(B_ + 3 * TC * 64 + o_ + 4) = (f32x4){kk_[4], kk_[5], kk_[6], kk_[7]}; \
        *(LAS f32x4*)(B_ + 4 * TC * 64 + o_) = (f32x4){bb_[0], bb_[1], bb_[2], bb_[3]}; *(LAS f32x4*)(B_ + 4 * TC * 64 + o_ + 4) = (f32x4){bb_[4], bb_[5], bb_[6], bb_[7]}; \
        if (c8 < 2) { *(LAS f32x4*)(B_ + 5 * TC * 64 + tt * 16 + 8 * c8) = (f32x4){vs_[0], vs_[1], vs_[2], vs_[3]}; *(LAS f32x4*)(B_ + 5 * TC * 64 + tt * 16 + 8 * c8 + 4) = (f32x4){vs_[4], vs_[5], vs_[6], vs_[7]}; } } while (0)
    constexpr int NCH = SEQ / TC;
    if (prod) { SCAN_ISSUE(0); SCAN_FILL(0, lds); SCAN_ISSUE(1); }
    LDS_BARRIER();
    const int rowl = (tid >> 4) & 15, kl = tid & 15;
    f32x2 S01 = (f32x2){0.f, 0.f}, S23 = (f32x2){0.f, 0.f};
    float ykeep = 0.f;
    float* Yp = (float*)(F.ws + WS_Y) + (size_t)b * SEQ * 1024 + h * 64 + 16 * rg + rowl + (size_t)kl * 1024;
    for (int c = 0; c < NCH; ++c) {
        if (prod) {
            if (c + 1 < NCH) { SCAN_FILL(c + 1, lds + ((c + 1) & 1) * SBUF_F); if (c + 2 < NCH) SCAN_ISSUE(c + 2); }
        } else {
            const LAS float* B = lds + (c & 1) * SBUF_F;
            const LAS f32x4* R4 = (const LAS f32x4*)B + kl; const LAS f32x4* W4 = (const LAS f32x4*)(B + TC * 64) + kl; const LAS f32x4* KM4 = (const LAS f32x4*)(B + 2 * TC * 64) + kl;
            const LAS f32x4* KK4 = (const LAS f32x4*)(B + 3 * TC * 64) + kl; const LAS f32x4* BB4 = (const LAS f32x4*)(B + 4 * TC * 64) + kl; const LAS float* V1 = B + 5 * TC * 64 + rowl;
            f32x4 kk = KK4[0], wv4 = W4[0], bb = BB4[0], km = KM4[0], r4 = R4[0]; float vv = V1[0];
#pragma unroll
            for (int t = 0; t < TC; ++t) {
                f32x4 kk_n = kk, wv_n = wv4, bb_n = bb, km_n = km, r_n = r4; float vv_n = vv;
                if (t + 1 < TC) { kk_n = KK4[(t + 1) * 16]; wv_n = W4[(t + 1) * 16]; bb_n = BB4[(t + 1) * 16]; km_n = KM4[(t + 1) * 16]; r_n = R4[(t + 1) * 16]; vv_n = V1[(t + 1) * 16]; }
                f32x2 d2 = S01 * (f32x2){kk.x, kk.y}; d2 = S23 * (f32x2){kk.z, kk.w} + d2;
                const f32x2 t01 = (f32x2){km.x, km.y} * vv, t23 = (f32x2){km.z, km.w} * vv;
                float sa = d2.x + d2.y; sa = allred16(sa);
                S01 = S01 * (f32x2){wv4.x, wv4.y} + (t01 - (f32x2){bb.x, bb.y} * sa);
                S23 = S23 * (f32x2){wv4.z, wv4.w} + (t23 - (f32x2){bb.z, bb.w} * sa);
                f32x2 y2 = S01 * (f32x2){r4.x, r4.y}; y2 = S23 * (f32x2){r4.z, r4.w} + y2;
                float y = y2.x + y2.y; y = allred16(y);
                ykeep = (kl == (t & 15)) ? y : ykeep;
                if ((t & 15) == 15) Yp[(size_t)(c * TC + t - 15) * 1024] = ykeep;
                kk = kk_n; wv4 = wv_n; bb = bb_n; km = km_n; r4 = r_n; vv = vv_n;
            }
        }
        LDS_BARRIER();
    }
#undef SCAN_ISSUE
#undef SCAN_FILL
}
typedef short bf16x4 __attribute__((ext_vector_type(4)));
#define MM32(a, b, c) __builtin_amdgcn_mfma_f32_16x16x32_bf16((a), (b), (c), 0, 0, 0)
typedef short bf16x4_fwd __attribute__((ext_vector_type(4)));
#define MM16_HW(a, b, c) __builtin_amdgcn_mfma_f32_16x16x16bf16_1k((a), (b), (c), 0, 0, 0)
__device__ __forceinline__ f32x4 mm16_emul(const bf16x4 a, const bf16x4 b, const f32x4 c) {
    const bf16x8 a8 = {a[0], a[1], a[2], a[3], 0, 0, 0, 0}, b8 = {b[0], b[1], b[2], b[3], 0, 0, 0, 0};
    return __builtin_amdgcn_mfma_f32_16x16x32_bf16(a8, b8, c, 0, 0, 0); }
#define MM16(a, b, c) mm16_emul((a), (b), (c))
typedef __bf16 bf16x2_t __attribute__((ext_vector_type(2)));
__device__ __forceinline__ unsigned cvtpk_c(float lo, float hi) { const f32x2 v = {lo, hi}; return __builtin_bit_cast(unsigned, __builtin_convertvector(v, bf16x2_t)); }
__device__ __forceinline__ bf16x4 pack4(const f32x4 v) { v2u r; r.x = cvtpk_c(v.x, v.y); r.y = cvtpk_c(v.z, v.w); return __builtin_bit_cast(bf16x4, r); }
__device__ __forceinline__ bf16x8 pack8(const f32x4 a, const f32x4 b) { v4u r; r.x = cvtpk_c(a.x, a.y); r.y = cvtpk_c(a.z, a.w); r.z = cvtpk_c(b.x, b.y); r.w = cvtpk_c(b.z, b.w); return __builtin_bit_cast(bf16x8, r); }
constexpr size_t Z_UNIT = 12800, WS_Z = 1 * MiB, WS_Y2 = WS_H;
constexpr int PRE_LDS_WAVE = 6912;
__device__ __forceinline__ void rwkv_pre(const Frame& F) {
    const int lane = F.lane, q = lane >> 4, c15 = lane & 15;
    const int bh = F.gw & 31, b = bh >> 4, h = bh & 15;
    const bf16* P = (const bf16*)(F.ws + WS_P); const bf16* LO = (const bf16*)(F.ws + WS_LORA);
    LAS bf16* KKs = (LAS bf16*)(F.lds + F.wave * PRE_LDS_WAVE); LAS bf16* Bs = KKs + 1088; LAS bf16* KMs = KKs + 2176; LAS float* gTs = (LAS float*)(KKs + 3264);
    float mur[16], muk[16], kkc[16], kac[16];
#pragma unroll
    for (int e = 0; e < 16; ++e) { const int ch = h * 64 + 16 * (e >> 2) + 4 * q + (e & 3); mur[e] = F.in[I_MU][ch]; muk[e] = F.in[I_MU][1024 + ch]; kkc[e] = F.in[I_KK][ch]; kac[e] = F.in[I_KA][ch]; }
    const f32x4 z4 = (f32x4){0.f, 0.f, 0.f, 0.f};
    for (int c = F.gw >> 5; c < 256; c += F.NGW >> 5) {
        const int t = 16 * c + c15; const size_t row = (size_t)b * SEQ + t, prow = t ? row - 1 : row; const float pz = t ? 1.f : 0.f;
        float rs[16], kk[16], km[16], bb[16], lw[16]; float ssq = 0.f;
#pragma unroll
        for (int a = 0; a < 4; ++a) {
            const int co = h * 64 + 16 * a + 4 * q;
            const v2u rc = *(const v2u*)(P + row * PW + RR + co), rp = *(const v2u*)(P + prow * PW + RR + co), kc = *(const v2u*)(P + row * PW + RK + co), kp = *(const v2u*)(P + prow * PW + RK + co);
            const v2u wv = *(const v2u*)(LO + row * NLORA + co), av = *(const v2u*)(LO + row * NLORA + 1024 + co);
            const float rcf[4] = {bflo(rc.x), bfhi(rc.x), bflo(rc.y), bfhi(rc.y)}, rpf[4] = {bflo(rp.x), bfhi(rp.x), bflo(rp.y), bfhi(rp.y)};
            const float kcf[4] = {bflo(kc.x), bfhi(kc.x), bflo(kc.y), bfhi(kc.y)}, kpf[4] = {bflo(kp.x), bfhi(kp.x), bflo(kp.y), bfhi(kp.y)};
            const float wf[4] = {bflo(wv.x), bfhi(wv.x), bflo(wv.y), bfhi(wv.y)}, af[4] = {bflo(av.x), bfhi(av.x), bflo(av.y), bfhi(av.y)};
#pragma unroll
            for (int i = 0; i < 4; ++i) { const int e = 4 * a + i;
                rs[e] = rcf[i] + mur[e] * (rpf[i] * pz - rcf[i]); const float ks = kcf[i] + muk[e] * (kpf[i] * pz - kcf[i]);
                const float kr = ks * kkc[e]; ssq += kr * kr; kk[e] = kr; bb[e] = af[i]; km[e] = ks * (1.0f + (af[i] - 1.0f) * kac[e]); lw[e] = __logf(1.0f - wf[i]); }
        }
        ssq += __shfl_xor(ssq, 16); ssq += __shfl_xor(ssq, 32);
        const float inv = 1.0f / fmaxf(sqrtf(ssq), 1e-12f);
        float KKt[16], Bt[16], KMt[16], Rt[16];
#pragma unroll
        for (int e = 0; e < 16; ++e) {
            float cum = lw[e]; cum += dppf<0x111>(cum); cum += dppf<0x112>(cum); cum += dppf<0x114>(cum); cum += dppf<0x118>(cum);
            const float g = __expf(cum), gm1 = __expf(cum - lw[e]), ig = __expf(-cum);
            const float kkn = kk[e] * inv;
            KKt[e] = gm1 * kkn; Bt[e] = kkn * bb[e] * ig; KMt[e] = km[e] * ig; Rt[e] = g * rs[e];
            if (c15 == 15) gTs[16 * (e >> 2) + 4 * q + (e & 3)] = g;
        }
#pragma unroll
        for (int a = 0; a < 4; ++a) { const int o = c15 * 68 + 16 * a + 4 * q;
            v2u w; w.x = cvtpk_c(KKt[4 * a], KKt[4 * a + 1]); w.y = cvtpk_c(KKt[4 * a + 2], KKt[4 * a + 3]); *(LAS v2u*)(KKs + o) = w;
            w.x = cvtpk_c(Bt[4 * a], Bt[4 * a + 1]); w.y = cvtpk_c(Bt[4 * a + 2], Bt[4 * a + 3]); *(LAS v2u*)(Bs + o) = w;
            w.x = cvtpk_c(KMt[4 * a], KMt[4 * a + 1]); w.y = cvtpk_c(KMt[4 * a + 2], KMt[4 * a + 3]); *(LAS v2u*)(KMs + o) = w; }
        bf16x8 KK8[2], B8[2], KM8[2], R8[2];
#pragma unroll
        for (int s = 0; s < 2; ++s) {
            KK8[s] = pack8((f32x4){KKt[8 * s], KKt[8 * s + 1], KKt[8 * s + 2], KKt[8 * s + 3]}, (f32x4){KKt[8 * s + 4], KKt[8 * s + 5], KKt[8 * s + 6], KKt[8 * s + 7]});
            B8[s] = pack8((f32x4){Bt[8 * s], Bt[8 * s + 1], Bt[8 * s + 2], Bt[8 * s + 3]}, (f32x4){Bt[8 * s + 4], Bt[8 * s + 5], Bt[8 * s + 6], Bt[8 * s + 7]});
            KM8[s] = pack8((f32x4){KMt[8 * s], KMt[8 * s + 1], KMt[8 * s + 2], KMt[8 * s + 3]}, (f32x4){KMt[8 * s + 4], KMt[8 * s + 5], KMt[8 * s + 6], KMt[8 * s + 7]});
            R8[s] = pack8((f32x4){Rt[8 * s], Rt[8 * s + 1], Rt[8 * s + 2], Rt[8 * s + 3]}, (f32x4){Rt[8 * s + 4], Rt[8 * s + 5], Rt[8 * s + 6], Rt[8 * s + 7]});
        }
        f32x4 M1T = MM32(KK8[1], KM8[1], MM32(KK8[0], KM8[0], z4));
        f32x4 X = MM32(B8[1], KK8[1], MM32(B8[0], KK8[0], z4));
        f32x4 XT = MM32(KK8[1], B8[1], MM32(KK8[0], B8[0], z4));
        f32x4 N1 = MM32(KM8[1], R8[1], MM32(KM8[0], R8[0], z4));
        f32x4 N2 = MM32(B8[1], R8[1], MM32(B8[0], R8[0], z4));
        f32x4 W, WT;
#pragma unroll
        for (int i = 0; i < 4; ++i) { const int r4 = 4 * q + i; const float id = (r4 == c15) ? 1.f : 0.f;
            M1T[i] = (c15 < r4) ? M1T[i] : 0.f; X[i] = (r4 < c15) ? -X[i] : 0.f; XT[i] = (c15 < r4) ? -XT[i] : 0.f; N1[i] = (r4 <= c15) ? N1[i] : 0.f; N2[i] = (r4 <= c15) ? N2[i] : 0.f;
            W[i] = id + X[i]; WT[i] = id + XT[i]; }
#pragma unroll
        for (int lvl = 0; lvl < 3; ++lvl) {
            const bf16x4 xp = pack4(X), xtp = pack4(XT), wtp = pack4(WT);
            const f32x4 X2 = MM16(xtp, xp, z4), XT2 = MM16(xp, xtp, z4);
            const bf16x4 x2p = pack4(X2);
            W = MM16(wtp, x2p, W); WT = MM16(x2p, wtp, WT);
            X = X2; XT = XT2;
        }
        const bf16x4 wtp = pack4(WT), m1p = pack4(M1T);
        const f32x4 WN2 = MM16(wtp, pack4(N2), z4);
        const bf16x4 wn2p = pack4(WN2);
        const f32x4 Th = N1 - MM16(m1p, wn2p, z4);
        asm volatile("s_waitcnt lgkmcnt(0)" ::: "memory");
        bf16x4 KKT[4], BT[4]; float KMTf[4][4], gTv[4];
#pragma unroll
        for (int a = 0; a < 4; ++a) {
            bf16x4 k4, b4;
#pragma unroll
            for (int i = 0; i < 4; ++i) { const int o = (4 * q + i) * 68 + 16 * a + c15; k4[i] = (short)KKs[o]; b4[i] = (short)Bs[o]; KMTf[a][i] = bf1(KMs[o]); }
            KKT[a] = k4; BT[a] = b4; gTv[a] = gTs[16 * a + c15];
        }
        unsigned char* Zu = F.ws + WS_Z + (size_t)(bh * 256 + c) * Z_UNIT;
        bf16x4 wbp[4];
#pragma unroll
        for (int a = 0; a < 4; ++a) { const f32x4 WB = MM16(wtp, BT[a], z4); wbp[a] = pack4(WB);
            f32x4 Ps = MM16(m1p, wbp[a], z4);
#pragma unroll
            for (int i = 0; i < 4; ++i) Ps[i] = (KMTf[a][i] - Ps[i]) * gTv[a];
            *(bf16x4*)(Zu + 8192 + (a * 64 + lane) * 8) = pack4(Ps); }
        f32x4 Om[4];
#pragma unroll
        for (int a = 0; a < 4; ++a) { const f32x4 mm = MM16(KKT[a], wn2p, z4);
#pragma unroll
            for (int i = 0; i < 4; ++i) Om[a][i] = Rt[4 * a + i] - mm[i]; }
        *(bf16x8*)(Zu + 10240 + (0 * 64 + lane) * 16) = pack8(Om[0], Om[1]); *(bf16x8*)(Zu + 10240 + (1 * 64 + lane) * 16) = pack8(Om[2], Om[3]);
        *(bf16x4*)(Zu + 12288 + lane * 8) = pack4(Th);
#pragma unroll
        for (int bt = 0; bt < 4; ++bt) {
            f32x4 Ph[4];
#pragma unroll
            for (int a = 0; a < 4; ++a) { const f32x4 mm = MM16(KKT[a], wbp[bt], z4);
#pragma unroll
                for (int i = 0; i < 4; ++i) Ph[a][i] = (((16 * a + 4 * q + i) == (16 * bt + c15) ? 1.f : 0.f) - mm[i]) * gTv[bt]; }
            *(bf16x8*)(Zu + ((bt * 2 + 0) * 64 + lane) * 16) = pack8(Ph[0], Ph[1]); *(bf16x8*)(Zu + ((bt * 2 + 1) * 64 + lane) * 16) = pack8(Ph[2], Ph[3]);
        }
        asm volatile("s_waitcnt lgkmcnt(0)" ::: "memory");
    }
}
constexpr int GC = 4, CH_LDS = 12800 + 17 * 128, NGRP = 256 / GC, ZP = GC * 800, VP = GC * 136, ZL = (ZP + 255) / 256, VL = (VP + 255) / 256;
__device__ __forceinline__ void rwkv_apply(const Frame& F, int bh) {
    const int lane = F.lane, q = lane >> 4, c15 = lane & 15, b = bh >> 4, h = bh & 15, w = F.wave & 3;
    const bool loader = F.wave >= 4; const int l256 = F.tid & 255;
    const unsigned char* Zb = F.ws + WS_Z + (size_t)bh * 256 * Z_UNIT;
    const bf16* Pv = (const bf16*)(F.ws + WS_P) + (size_t)b * SEQ * PW + RV + h * 64;
    LAS unsigned char* ring = F.lds;
    v4u zrA[ZL], vrA[VL], zrB[ZL], vrB[VL];
#define AP_ISSUE(g, zr, vr) do { _Pragma("unroll") for (int k = 0; k < ZL; ++k) { int p = l256 + 256 * k; p = p < ZP ? p : ZP - 1; const int j = p / 800, off = p - j * 800; zr[k] = *(const v4u*)(Zb + (size_t)((g) * GC + j) * Z_UNIT + off * 16); } \
        _Pragma("unroll") for (int k = 0; k < VL; ++k) { int p = l256 + 256 * k; p = p < VP ? p : VP - 1; const int j = p / 136, r = p - j * 136, tok = r >> 3, pc = r & 7; int t = 16 * ((g) * GC + j) - 1 + tok; t = t < 0 ? 0 : t; \
            vr[k] = *(const v4u*)(Pv + (size_t)t * PW + 8 * pc); } } while (0)
#define AP_WRITE(bufi, zr, vr) do { LAS unsigned char* B_ = ring + (bufi) * (GC * CH_LDS); _Pragma("unroll") for (int k = 0; k < ZL; ++k) { const int p = l256 + 256 * k; if (p < ZP) { const int j = p / 800, off = p - j * 800; *(LAS v4u*)(B_ + j * CH_LDS + off * 16) = zr[k]; } } \
        _Pragma("unroll") for (int k = 0; k < VL; ++k) { const int p = l256 + 256 * k; if (p < VP) { const int j = p / 136, r = p - j * 136; *(LAS v4u*)(B_ + j * CH_LDS + 12800 + r * 16) = vr[k]; } } } while (0)
    if (loader) {
        AP_ISSUE(0, zrA, vrA); AP_ISSUE(1, zrB, vrB); AP_WRITE(0, zrA, vrA); AP_ISSUE(2, zrA, vrA);
        LDS_BARRIER();
        for (int g = 0; g < NGRP; g += 2) {
            if (g + 1 < NGRP) { AP_WRITE(1, zrB, vrB); if (g + 3 < NGRP) AP_ISSUE(g + 3, zrB, vrB); }
            LDS_BARRIER();
            if (g + 2 < NGRP) { AP_WRITE(0, zrA, vrA); if (g + 4 < NGRP) AP_ISSUE(g + 4, zrA, vrA); }
            LDS_BARRIER();
        }
    } else {
        const float muv = F.in[I_MU][2048 + h * 64 + 16 * w + c15];
        bf16* Yb = (bf16*)(F.ws + WS_Y2) + (size_t)b * SEQ * 1024 + h * 64 + 16 * w + c15;
        const f32x4 z4 = (f32x4){0.f, 0.f, 0.f, 0.f};
        f32x4 S[4] = {z4, z4, z4, z4};
        LDS_BARRIER();
        for (int g = 0; g < NGRP; ++g) {
            const LAS unsigned char* B = ring + (g & 1) * (GC * CH_LDS);
            bf16x8 oPh[4][2], oOm[2]; bf16x4 oPs[4], oTh; float ovr[5];
#define AP_LD(Zu_) do { const LAS unsigned char* Z_ = (Zu_); _Pragma("unroll") for (int ao = 0; ao < 4; ++ao) { oPh[ao][0] = *(const LAS bf16x8*)(Z_ + ((ao * 2 + 0) * 64 + lane) * 16); oPh[ao][1] = *(const LAS bf16x8*)(Z_ + ((ao * 2 + 1) * 64 + lane) * 16); \
                oPs[ao] = *(const LAS bf16x4*)(Z_ + 8192 + (ao * 64 + lane) * 8); } oOm[0] = *(const LAS bf16x8*)(Z_ + 10240 + lane * 16); oOm[1] = *(const LAS bf16x8*)(Z_ + 10240 + (64 + lane) * 16); oTh = *(const LAS bf16x4*)(Z_ + 12288 + lane * 8); \
                const LAS bf16* Vs_ = (const LAS bf16*)(Z_ + 12800) + 16 * w + c15; _Pragma("unroll") for (int n = 0; n < 5; ++n) ovr[n] = bf1(Vs_[(4 * q + n) * 64]); } while (0)
            AP_LD(B);
#pragma unroll
            for (int j = 0; j < GC; ++j) {
                const int c = g * GC + j;
                bf16x8 Ph[4][2], Om[2]; bf16x4 Ps[4], Th; float vraw[5];
#pragma unroll
                for (int ao = 0; ao < 4; ++ao) { Ph[ao][0] = oPh[ao][0]; Ph[ao][1] = oPh[ao][1]; Ps[ao] = oPs[ao]; }
                Om[0] = oOm[0]; Om[1] = oOm[1]; Th = oTh;
#pragma unroll
                for (int n = 0; n < 5; ++n) vraw[n] = ovr[n];
                if (j + 1 < GC) { AP_LD(B + (j + 1) * CH_LDS); }
                __builtin_amdgcn_sched_barrier(0);
                if (c == 0 && q == 0) vraw[0] = 0.f;
                f32x4 vs;
#pragma unroll
                for (int i = 0; i < 4; ++i) vs[i] = vraw[i + 1] + muv * (vraw[i] - vraw[i + 1]);
                const bf16x4 BV = pack4(vs);
                const bf16x8 Sb0 = pack8(S[0], S[1]), Sb1 = pack8(S[2], S[3]);
                f32x4 y = MM16(Th, BV, z4), n0 = MM16(Ps[0], BV, z4), n1 = MM16(Ps[1], BV, z4), n2 = MM16(Ps[2], BV, z4), n3 = MM16(Ps[3], BV, z4);
                y = MM32(Om[0], Sb0, y); n0 = MM32(Ph[0][0], Sb0, n0); n1 = MM32(Ph[1][0], Sb0, n1); n2 = MM32(Ph[2][0], Sb0, n2); n3 = MM32(Ph[3][0], Sb0, n3);
                y = MM32(Om[1], Sb1, y); n0 = MM32(Ph[0][1], Sb1, n0); n1 = MM32(Ph[1][1], Sb1, n1); n2 = MM32(Ph[2][1], Sb1, n2); n3 = MM32(Ph[3][1], Sb1, n3);
                S[0] = n0; S[1] = n1; S[2] = n2; S[3] = n3;
                const int t0 = 16 * c + 4 * q;
#pragma unroll
                for (int i = 0; i < 4; ++i) Yb[(size_t)(t0 + i) * 1024] = (bf16)f2bf(y[i]);
            }
#undef AP_LD
            LDS_BARRIER();
        }
    }
#undef AP_ISSUE
#undef AP_WRITE
}
__device__ __forceinline__ void unpack8(const v4u u, float (&f)[8]) { f[0] = bflo(u.x); f[1] = bfhi(u.x); f[2] = bflo(u.y); f[3] = bfhi(u.y); f[4] = bflo(u.z); f[5] = bfhi(u.z); f[6] = bflo(u.w); f[7] = bfhi(u.w); }
__device__ __forceinline__ void rwkv_post(const Frame& F) {
    const bf16* P = (const bf16*)(F.ws + WS_P); const bf16* LO = (const bf16*)(F.ws + WS_LORA); const bf16* Y = (const bf16*)(F.ws + WS_Y2); bf16* OR = (bf16*)(F.ws + WS_ORW);
    const int h = F.gw & 15, sub = F.lane & 7, tk = F.lane >> 3, ch0 = h * 64 + 8 * sub;
    float mur[8], muk[8], muv[8], ka[8], rk[8], lw[8], lb[8];
#pragma unroll
    for (int j = 0; j < 8; ++j) { const int ch = ch0 + j; mur[j] = F.in[I_MU][ch]; muk[j] = F.in[I_MU][1024 + ch]; muv[j] = F.in[I_MU][2048 + ch]; ka[j] = F.in[I_KA][ch]; rk[j] = F.in[I_RK][ch]; lw[j] = F.in[I_LNW][ch]; lb[j] = F.in[I_LNB][ch]; }
    for (int m = (F.gw >> 4) * 8 + tk; m < M; m += (F.NGW >> 4) * 8) {
        const bool first = (m % SEQ) == 0; const size_t row = m, prow = first ? m : m - 1; const float pz = first ? 0.f : 1.f;
        float rc[8], rp[8], kc[8], kp[8], vc[8], vp[8], av[8], gv[8], yv[8];
        unpack8(*(const v4u*)(P + row * PW + RR + ch0), rc); unpack8(*(const v4u*)(P + prow * PW + RR + ch0), rp); unpack8(*(const v4u*)(P + row * PW + RK + ch0), kc); unpack8(*(const v4u*)(P + prow * PW + RK + ch0), kp);
        unpack8(*(const v4u*)(P + row * PW + RV + ch0), vc); unpack8(*(const v4u*)(P + prow * PW + RV + ch0), vp);
        unpack8(*(const v4u*)(LO + row * NLORA + 1024 + ch0), av); unpack8(*(const v4u*)(LO + row * NLORA + 2048 + ch0), gv); unpack8(*(const v4u*)(Y + row * 1024 + ch0), yv);
        float dot = 0.f, sum = 0.f, vs[8];
#pragma unroll
        for (int j = 0; j < 8; ++j) { const float rs = rc[j] + mur[j] * (rp[j] * pz - rc[j]), ks = kc[j] + muk[j] * (kp[j] * pz - kc[j]); vs[j] = vc[j] + muv[j] * (vp[j] * pz - vc[j]);
            dot += rs * (ks * (1.0f + (av[j] - 1.0f) * ka[j])) * rk[j]; sum += yv[j]; }
        dot = allred8(dot); const float mean = allred8(sum) * (1.0f / 64.0f);
        float sq = 0.f;
#pragma unroll
        for (int j = 0; j < 8; ++j) { yv[j] -= mean; sq += yv[j] * yv[j]; }
        const float rstd = rsqrtf(allred8(sq) * (1.0f / 64.0f) + 64e-5f);
        float o[8];
#pragma unroll
        for (int j = 0; j < 8; ++j) o[j] = (yv[j] * rstd * lw[j] + lb[j] + dot * vs[j]) * gv[j];
        v4u w; w.x = pk2(o[0], o[1]); w.y = pk2(o[2], o[3]); w.z = pk2(o[4], o[5]); w.w = pk2(o[6], o[7]);
        *(v4u*)(OR + row * 1024 + ch0) = w;
    }
}
#ifndef MK_SPLIT
#define MK_SPLIT 0
#endif
constexpr int NPHASE = 15;
struct Args { const float* in[29]; float* out; unsigned char* ws; int ph_lo, ph_hi; };
__global__ void __launch_bounds__(512, 2) fwd_mega(Args args) {
    extern __shared__ __attribute__((aligned(16))) unsigned char lds_raw[];
    cg::grid_group grid = cg::this_grid();
    Frame F;
    F.lds = (LAS unsigned char*)lds_raw;
    F.tid = threadIdx.x; F.lane = F.tid & 63; F.wave = __builtin_amdgcn_readfirstlane(F.tid >> 6);
    F.G = gridDim.x; F.gw = blockIdx.x * 8 + F.wave; F.NGW = F.G * 8;
#pragma unroll
    for (int i = 0; i < 29; ++i) F.in[i] = args.in[i];
    F.out = args.out; F.ws = args.ws;
    unsigned char* ws = args.ws;
    const int lo = args.ph_lo, hi = args.ph_hi, bid = blockIdx.x;
    volatile LAS unsigned* xst = (volatile LAS unsigned*)(F.lds + LDS_BYTES - 64);
    if (F.tid == 0) { xst[0] = 0u; xst[1] = 0u; }
    unsigned* barw = (unsigned*)(ws + WS_BAR);
    if (bid == 0) for (int i = F.tid; i < XCD_BAR_WORDS; i += 512) barw[i] = 0u;
    __syncthreads();
    bf16* H = (bf16*)(ws + WS_H); float* X1 = (float*)(ws + WS_X1); bf16* Pb = (bf16*)(ws + WS_P); bf16* ACT = (bf16*)(ws + WS_ACT);
#define IN(k) (lo <= (k) && (k) < hi)
#define SEAM(k) xcd_barrier(xbar)
#define SEAM2(k) xcd_barrier(xbar)
#define GEMM_PHASE(EPI, Aptr, Bptr, N_, K_, ...) do { pg8::Gemm g{(const pg8::bf16_t*)(Aptr), (const pg8::bf16_t*)(Bptr), M, (N_), (K_)}; pg8::StaticOrder S; S.init(M, (N_), F.G, bid); \
        EPI E{__VA_ARGS__}; pg8::gemm_phase<EPI, pg8::StaticOrder, true, true>(F.lds, g, S, E); } while (0)

    if (IN(0)) { p_prologue(F); }
    grid.sync();
    const XcdBarrier xbar = xcd_barrier_post(barw, xst);
    if (IN(1)) { GEMM_PHASE(pg8::EpiSwiglu, H, ws + WS_WUP, NUP, D, ACT, FF, nullptr);
        { const int nfull = (32 * (NUP / 256)) % F.G, ne = F.G - nfull; const bool early = nfull && bid >= nfull; const int w0 = early ? (bid - nfull) * 8 + F.wave : F.gw, nw = nfull ? ne * 8 : F.NGW;
          if (early || !nfull) { convert_ffn_dn(F, 0, (bf16*)(ws + WS_WDN), w0, nw); tr_job(F, SrcWin{F.in[I_WIN]}, D_IN, (bf16*)(ws + WS_WIN), D, PW, w0, nw); } } } SEAM(1);
    if (IN(2)) { GEMM_PHASE(pg8::EpiResid, ACT, ws + WS_WDN, D, FF, F.in[I_X], X1, D, 0.5f, H, F.in[I_NMIX], (float*)(ws + WS_SS1)); } SEAM2(2);
    if (IN(4)) { GEMM_PHASE(pg8::EpiWin, H, ws + WS_WIN, PW, D, Pb, PW, F.in[I_GATEB], GG / 256, SM / 256, (const float*)(ws + WS_SS1));
        { const int nfull = (32 * (PW / 256)) % F.G, ne = F.G - nfull; const bool early = nfull && bid >= nfull; const int w0 = early ? (bid - nfull) * 8 + F.wave : F.gw, nw = nfull ? ne * 8 : F.NGW;
          if (early || !nfull) { tr_job(F, SrcPlain{F.in[I_WBR]}, D, (bf16*)(ws + WS_WBR1), 1024, D, w0, nw); tr_job(F, SrcPlain{F.in[I_WBR] + (size_t)1024 * D}, D, (bf16*)(ws + WS_WBR2), 1024, D, w0, nw);
              tr_job(F, SrcPlain{F.in[I_WOUT]}, D, (bf16*)(ws + WS_WOUT), D, D, w0, nw); } } } SEAM(4);
    if (IN(5)) { p_lora_a(F); for (int u = bid; u < 512; u += F.G) gla_u_unit(F, u); } SEAM(5);
    if (IN(6)) { { int klora = 256; asm volatile("" : "+s"(klora));
          pg8::Gemm g{(const pg8::bf16_t*)(ws + WS_ALORA), (const pg8::bf16_t*)(ws + WS_WLORA), M, NLORA, klora}; pg8::LoraOrder S; S.S.init(M, NLORA, F.G, bid);
          pg8::EpiLora E{(bf16*)(ws + WS_LORA), NLORA, F.in[I_W0], F.in[I_A0]}; pg8::gemm_phase<pg8::EpiLora, pg8::LoraOrder, true, true>(F.lds, g, S, E); }
        gla_chain(F); } SEAM(6);
    if (IN(7)) {
        rwkv_pre(F); __syncthreads();
        for (int u = bid; u < 512; u += F.G) gla_o_unit(F, u);
        xcd_barrier(xbar);
        if (F.G > 64) { if (bid < 32) rwkv_apply(F, bid);
            else { convert_ffn_up(F, 1, (bf16*)args.out, (bid - 32) * 8 + F.wave, (F.G - 32) * 8); __syncthreads();
                pg8::Gemm g{(const pg8::bf16_t*)(ws + WS_OGLA), (const pg8::bf16_t*)(ws + WS_WBR1), M, D, 1024}; pg8::StaticOrder S; S.init(M, D, F.G - 32, bid - 32);
                pg8::EpiGate<false> E{Pb + GG, PW, Pb + GG, PW}; pg8::gemm_phase<pg8::EpiGate<false>, pg8::StaticOrder, true, true>(F.lds, g, S, E); } }
        else { for (int id = bid; id < 32; id += F.G) rwkv_apply(F, id); convert_ffn_up(F, 1, (bf16*)args.out, F.gw, F.NGW); __syncthreads();
            GEMM_PHASE(pg8::EpiGate<false>, ws + WS_OGLA, ws + WS_WBR1, D, 1024, Pb + GG, PW, Pb + GG, PW); }
    } SEAM(7);
    if (IN(8)) { rwkv_post(F); } SEAM(8);
    if (IN(9)) {
        GEMM_PHASE(pg8::EpiGate<true>, ws + WS_ORW, ws + WS_WBR2, D, 1024, Pb + GR, PW, Pb + GG, PW);
    } SEAM(9);
    if (IN(10)) { pg8::Gemm g{(const pg8::bf16_t*)(Pb + GG), (const pg8::bf16_t*)(ws + WS_WOUT), M, D, D, PW, 0}; pg8::StaticOrder S; S.init(M, D, F.G, bid);
        pg8::EpiResid E{X1, X1, D, 1.0f, H, F.in[I_N2], (float*)(ws + WS_SS2)}; pg8::gemm_phase<pg8::EpiResid, pg8::StaticOrder, true, true>(F.lds, g, S, E); } SEAM2(10);
    if (IN(12)) { GEMM_PHASE(pg8::EpiSwiglu, H, args.out, NUP, D, ACT, FF, (const float*)(ws + WS_SS2));
        { const int nfull = (32 * (NUP / 256)) % F.G, ne = F.G - nfull; const bool early = nfull && bid >= nfull; const int w0 = early ? (bid - nfull) * 8 + F.wave : F.gw, nw = nfull ? ne * 8 : F.NGW;
          if (early || !nfull) convert_ffn_dn(F, 1, (bf16*)(ws + WS_WDN2), w0, nw); } } SEAM(12);
    if (IN(13)) { GEMM_PHASE(pg8::EpiResid, ACT, ws + WS_WDN2, D, FF, X1, nullptr, D, 0.5f, H, F.in[I_NF], (float*)(ws + WS_SS3)); } SEAM(13);
    if (IN(14)) { final_scale(F, H, (const float*)(ws + WS_SS3), args.out); }
#undef IN
#undef SEAM
#undef GEMM_PHASE
}

extern "C" void kernel_launch(void* const* d_in, const int* in_sizes, int n_in, void* d_out, int out_size, void* d_ws, size_t ws_size, hipStream_t stream) {
    static int grid = 0;
    if (grid == 0) {
        if (n_in != 29 || out_size != M * D || ws_size < WS_END) { fprintf(stderr, "kernel_launch: unexpected shapes (n_in %d out %d ws %zu)\n", n_in, out_size, ws_size); grid = -1; return; }
        int dev = 0, cus = 0, per_cu = 0;
        hipGetDevice(&dev); hipDeviceGetAttribute(&cus, hipDeviceAttributeMultiprocessorCount, dev);
        hipFuncSetAttribute((const void*)fwd_mega, hipFuncAttributeMaxDynamicSharedMemorySize, LDS_BYTES);
        if (hipOccupancyMaxActiveBlocksPerMultiprocessor(&per_cu, (const void*)fwd_mega, 512, LDS_BYTES) != hipSuccess || per_cu < 1) { fprintf(stderr, "kernel_launch: occupancy query says %d blocks per CU\n", per_cu); (void)hipGetLastError(); per_cu = 1; }
        grid = cus * (per_cu > 1 ? 1 : per_cu);
        fprintf(stderr, "kernel_launch: grid %d (cus %d, per_cu %d), ws %zu\n", grid, cus, per_cu, ws_size);
    }
    if (grid < 0) return;
    Args a{};
    for (int i = 0; i < 29; ++i) a.in[i] = (const float*)d_in[i];
    a.out = (float*)d_out; a.ws = (unsigned char*)d_ws;
#if MK_SPLIT
    for (int p = 0; p < NPHASE; ++p) { a.ph_lo = p; a.ph_hi = p + 1; hipLaunchKernelGGL(fwd_mega, dim3(grid), dim3(512), LDS_BYTES, stream, a); }
#else
    a.ph_lo = 0; a.ph_hi = NPHASE;
    void* kargs[] = {&a};
    hipError_t e = hipLaunchCooperativeKernel((void*)fwd_mega, dim3(grid), dim3(512), kargs, LDS_BYTES, stream);
    if (e != hipSuccess) fprintf(stderr, "kernel_launch: cooperative launch failed: %s (grid %d)\n", hipGetErrorString(e), grid);
#endif
}
```

```cpp
#include <hip/hip_runtime.h>
#include <hip/hip_cooperative_groups.h>
#include <cstdio>
#include <cstdint>
namespace cg = cooperative_groups;
namespace pg8 {
#define PG8_LAS __attribute__((address_space(3)))
typedef unsigned short bf16_t;
typedef short bf16x8 __attribute__((ext_vector_type(8)));
typedef float f32x4 __attribute__((ext_vector_type(4)));
typedef unsigned u32x4 __attribute__((ext_vector_type(4)));
constexpr int BM = 256, BK = 64, HALF = 128, HTB = HALF * BK * 2  , STAGE_BYTES = 8 * HTB, NXCD = 8, WGM = 8;

__host__ __device__ __forceinline__ int lds_byte(int r, int c) { const int st = (r >> 4) * 2 + (c >> 5), rr = r & 15, cc = c & 31, ob = rr * 64 + cc * 2; return st * 1024 + (ob ^ (((ob >> 9) & 1) << 5)); }
__host__ __device__ __forceinline__ void stage_rc(int b, int& R, int& C) { const int st = b / 1024, sb = b % 1024, swz = sb ^ (((sb >> 9) & 1) << 5); R = (st >> 1) * 16 + swz / 64; C = (st & 1) * 32 + (swz % 64) / 2; }
__host__ __device__ __forceinline__ int perm32(int rho) { const int n = rho >> 4, i = rho & 15; return 8 * (i >> 2) + 4 * n + (i & 3); }

struct Unit { int pm, pn; };
struct Gemm { const bf16_t* A; const bf16_t* Bt; int M, N, K; int lda, ldb; };

struct StaticOrder {
    int nM, nN, nwg, G, c;
    __host__ __device__ void init(int M, int N, int G_, int c_) { nM = M / BM; nN = N / BM; nwg = nM * nN; G = G_; c = c_; }
    __host__ __device__ bool next(int i, Unit& u) const {
        const long L = (long)i * G + c; if (L >= nwg) return false;
        int wgid = (int)L; { const int q = nwg / NXCD, r = nwg % NXCD, xcd = wgid % NXCD, off = wgid / NXCD; wgid = (xcd < r ? xcd * (q + 1) : r * (q + 1) + (xcd - r) * q) + off; }
        const int nig = WGM * nN, gid = wgid / nig, fm = gid * WGM, gsz = (nM - fm) < WGM ? (nM - fm) : WGM;
        u.pm = fm + ((wgid % nig) % gsz); u.pn = (wgid % nig) / gsz; return true;
    }
    __device__ __forceinline__ void a_ready(const Unit&) const {}
    __device__ __forceinline__ void done(const Unit&) const {}
};

struct LoraOrder { StaticOrder S;
    __device__ bool next(int i, Unit& u) const { if (!S.next(i, u)) return false; if (u.pn >= 8) u.pm += 32; return true; }
    __device__ __forceinline__ void a_ready(const Unit&) const {}
    __device__ __forceinline__ void done(const Unit&) const {} };
__device__ __forceinline__ unsigned cvt_pk_bf16(float lo, float hi) { unsigned r; asm volatile("v_cvt_pk_bf16_f32 %0, %1, %2" : "=v"(r) : "v"(lo), "v"(hi)); return r; }
typedef float f32x2 __attribute__((ext_vector_type(2)));
typedef unsigned u32x2 __attribute__((ext_vector_type(2)));
__device__ __forceinline__ float fast_sigmoid(float x) { return __builtin_amdgcn_rcpf(1.0f + __builtin_amdgcn_exp2f(-1.4426950408889634f * x)); }
__device__ __forceinline__ float fast_silu(float x) { return x * fast_sigmoid(x); }
__device__ __forceinline__ float bf_lo(unsigned u) { return __uint_as_float(u << 16); }
__device__ __forceinline__ float bf_hi(unsigned u) { return __uint_as_float(u & 0xffff0000u); }

struct EpiSwiglu {
    static constexpr bool PERM = true, AFTER_DRAIN = false;
    bf16_t* O; int ldc; const float* ss;
    __device__ __forceinline__ void operator()(const f32x4 (&acc)[2][2][4][2], const Unit& u, int wr, int wc, int fr, int fq) const {
        const int row0 = u.pm * BM + wr * 64 + fr, col0 = u.pn * HALF + wc * 32 + 8 * fq;
        float rsv[2][4];
#pragma unroll
        for (int ai = 0; ai < 2; ++ai)
#pragma unroll
            for (int m = 0; m < 4; ++m) rsv[ai][m] = ss ? ss[row0 + ai * HALF + m * 16] : 0.f;
#pragma unroll
        for (int ai = 0; ai < 2; ++ai)
#pragma unroll
            for (int m = 0; m < 4; ++m) {
                bf16_t* rowp = O + (size_t)(row0 + ai * HALF + m * 16) * ldc + col0;
                const float rs = ss ? rsqrtf(rsv[ai][m] * (1.0f / 2048.0f) + 1e-6f) : 1.0f;
                const f32x4 g0 = acc[ai][0][m][0] * rs, g1 = acc[ai][0][m][1] * rs, u0 = acc[ai][1][m][0] * rs, u1 = acc[ai][1][m][1] * rs;
                u32x4 w;
                w.x = cvt_pk_bf16(fast_silu(g0[0]) * u0[0], fast_silu(g0[1]) * u0[1]); w.y = cvt_pk_bf16(fast_silu(g0[2]) * u0[2], fast_silu(g0[3]) * u0[3]);
                w.z = cvt_pk_bf16(fast_silu(g1[0]) * u1[0], fast_silu(g1[1]) * u1[1]); w.w = cvt_pk_bf16(fast_silu(g1[2]) * u1[2], fast_silu(g1[3]) * u1[3]);
                *(u32x4*)rowp = w;
            }
    }
};
struct EpiResid {
    static constexpr bool PERM = true, AFTER_DRAIN = false;
    const float* base; float* out; int ldc; float scale;
    bf16_t* Hn; const float* gn; float* ss;
    __device__ __forceinline__ void operator()(const f32x4 (&acc)[2][2][4][2], const Unit& u, int wr, int wc, int fr, int fq) const {
        const int row0 = u.pm * BM + wr * 64 + fr, col0 = u.pn * BM + wc * 32 + 8 * fq;
#pragma unroll
        for (int ai = 0; ai < 2; ++ai)
#pragma unroll
            for (int m = 0; m < 4; ++m) {
                const size_t off = (size_t)(row0 + ai * HALF + m * 16) * ldc + col0; float sq = 0.f;
#pragma unroll
                for (int bj = 0; bj < 2; ++bj) {
                    const f32x4 b0 = *(const f32x4*)(base + off + bj * HALF), b1 = *(const f32x4*)(base + off + bj * HALF + 4);
                    const f32x4 o0 = b0 + acc[ai][bj][m][0] * scale, o1 = b1 + acc[ai][bj][m][1] * scale;
                    if (out) { *(f32x4*)(out + off + bj * HALF) = o0; *(f32x4*)(out + off + bj * HALF + 4) = o1; }
                    if (Hn) { const f32x4 g0 = *(const f32x4*)(gn + col0 + bj * HALF), g1 = *(const f32x4*)(gn + col0 + bj * HALF + 4);
                        sq += (o0[0] * o0[0] + o0[1] * o0[1]) + (o0[2] * o0[2] + o0[3] * o0[3]) + (o1[0] * o1[0] + o1[1] * o1[1]) + (o1[2] * o1[2] + o1[3] * o1[3]);
                        u32x4 w; w.x = cvt_pk_bf16(o0[0] * g0[0], o0[1] * g0[1]); w.y = cvt_pk_bf16(o0[2] * g0[2], o0[3] * g0[3]); w.z = cvt_pk_bf16(o1[0] * g1[0], o1[1] * g1[1]); w.w = cvt_pk_bf16(o1[2] * g1[2], o1[3] * g1[3]);
                        *(u32x4*)(Hn + off + bj * HALF) = w; }
                }
                if (Hn) { sq += __shfl_xor(sq, 16); sq += __shfl_xor(sq, 32); if (fq == 0) atomicAdd(ss + row0 + ai * HALF + m * 16, sq); }
            }
    }
};
struct EpiWin {
    static constexpr bool PERM = true, AFTER_DRAIN = false;
    bf16_t* O; int ldc; const float* gate_b; int gt_lo, gt_hi; const float* ss;
    __device__ __forceinline__ void operator()(const f32x4 (&acc)[2][2][4][2], const Unit& u, int wr, int wc, int fr, int fq) const {
        const int row0 = u.pm * BM + wr * 64 + fr, col0 = u.pn * BM + wc * 32 + 8 * fq;
        const bool gate = (u.pn >= gt_lo && u.pn < gt_hi);
        float rsv[2][4];
#pragma unroll
        for (int ai = 0; ai < 2; ++ai)
#pragma unroll
            for (int m = 0; m < 4; ++m) rsv[ai][m] = ss ? ss[row0 + ai * HALF + m * 16] : 0.f;
        f32x4 bv[2][2];
#pragma unroll
        for (int bj = 0; bj < 2; ++bj)
#pragma unroll
            for (int n = 0; n < 2; ++n) bv[bj][n] = gate ? *(const f32x4*)(gate_b + (col0 - gt_lo * BM) + bj * HALF + 4 * n) : (f32x4){0.f, 0.f, 0.f, 0.f};
#pragma unroll
        for (int ai = 0; ai < 2; ++ai)
#pragma unroll
            for (int m = 0; m < 4; ++m) {
                bf16_t* rowp = O + (size_t)(row0 + ai * HALF + m * 16) * ldc + col0;
                const float rs = ss ? rsqrtf(rsv[ai][m] * (1.0f / 2048.0f) + 1e-6f) : 1.0f;
#pragma unroll
                for (int bj = 0; bj < 2; ++bj) {
                    f32x4 v0 = acc[ai][bj][m][0] * rs + bv[bj][0], v1 = acc[ai][bj][m][1] * rs + bv[bj][1];
                    if (gate) {
#pragma unroll
                        for (int j = 0; j < 4; ++j) { v0[j] = fast_sigmoid(v0[j]); v1[j] = fast_sigmoid(v1[j]); }
                    }
                    u32x4 w; w.x = cvt_pk_bf16(v0[0], v0[1]); w.y = cvt_pk_bf16(v0[2], v0[3]); w.z = cvt_pk_bf16(v1[0], v1[1]); w.w = cvt_pk_bf16(v1[2], v1[3]);
                    *(u32x4*)(rowp + bj * HALF) = w;
                }
            }
    }
};
struct EpiLora {
    static constexpr bool PERM = true, AFTER_DRAIN = false;
    bf16_t* O; int ldc; const float* w0; const float* a0;
    __device__ __forceinline__ void operator()(const f32x4 (&acc)[2][2][4][2], const Unit& u, int wr, int wc, int fr, int fq) const {
        const int row0 = (u.pm & 31) * BM + wr * 64 + fr, col0 = u.pn * BM + wc * 32 + 8 * fq;
        const int kind = u.pn >> 2, cl0 = col0 - kind * 1024;
        const float* bp = kind == 0 ? w0 : a0;
        f32x4 bv[2][2];
#pragma unroll
        for (int bj = 0; bj < 2; ++bj)
#pragma unroll
            for (int n = 0; n < 2; ++n) bv[bj][n] = kind < 2 ? *(const f32x4*)(bp + cl0 + bj * HALF + 4 * n) : (f32x4){0.f, 0.f, 0.f, 0.f};
#pragma unroll
        for (int ai = 0; ai < 2; ++ai)
#pragma unroll
            for (int m = 0; m < 4; ++m) {
                bf16_t* rowp = O + (size_t)(row0 + ai * HALF + m * 16) * ldc + col0;
#pragma unroll
                for (int bj = 0; bj < 2; ++bj) {
                    f32x4 v0 = acc[ai][bj][m][0] + bv[bj][0], v1 = acc[ai][bj][m][1] + bv[bj][1];
                    if (kind == 0) {
#pragma unroll
                        for (int j = 0; j < 4; ++j) { v0[j] = 1.0f - __builtin_amdgcn_exp2f(-0.875053085f * fast_sigmoid(v0[j])); v1[j] = 1.0f - __builtin_amdgcn_exp2f(-0.875053085f * fast_sigmoid(v1[j])); }
                    } else if (kind == 1) {
#pragma unroll
                        for (int j = 0; j < 4; ++j) { v0[j] = fast_sigmoid(v0[j]); v1[j] = fast_sigmoid(v1[j]); }
                    }
                    u32x4 w; w.x = cvt_pk_bf16(v0[0], v0[1]); w.y = cvt_pk_bf16(v0[2], v0[3]); w.z = cvt_pk_bf16(v1[0], v1[1]); w.w = cvt_pk_bf16(v1[2], v1[3]);
                    *(u32x4*)(rowp + bj * HALF) = w;
                }
            }
    }
};
template <bool ADD> struct EpiGate {
    static constexpr bool PERM = true, AFTER_DRAIN = false;
    const bf16_t* G; int ldg; bf16_t* T; int ldc;
    __device__ __forceinline__ void operator()(const f32x4 (&acc)[2][2][4][2], const Unit& u, int wr, int wc, int fr, int fq) const {
        const int row0 = u.pm * BM + wr * 64 + fr, col0 = u.pn * BM + wc * 32 + 8 * fq;
#pragma unroll
        for (int ai = 0; ai < 2; ++ai)
#pragma unroll
            for (int mp = 0; mp < 2; ++mp) {
                u32x4 gvv[2][2], tvv[2][2];
#pragma unroll
                for (int mm = 0; mm < 2; ++mm)
#pragma unroll
                    for (int bj = 0; bj < 2; ++bj) { const size_t r = (size_t)(row0 + ai * HALF + (2 * mp + mm) * 16); gvv[mm][bj] = *(const u32x4*)(G + r * ldg + col0 + bj * HALF);
                        if (ADD) tvv[mm][bj] = *(const u32x4*)(T + r * ldc + col0 + bj * HALF); }
#pragma unroll
                for (int mm = 0; mm < 2; ++mm) { const int m = 2 * mp + mm; const size_t r = (size_t)(row0 + ai * HALF + m * 16);
#pragma unroll
                    for (int bj = 0; bj < 2; ++bj) {
                        const u32x4 gv = gvv[mm][bj];
                        const f32x4 a0 = acc[ai][bj][m][0], a1 = acc[ai][bj][m][1];
                        float o[8] = {bf_lo(gv.x) * a0[0], bf_hi(gv.x) * a0[1], bf_lo(gv.y) * a0[2], bf_hi(gv.y) * a0[3], bf_lo(gv.z) * a1[0], bf_hi(gv.z) * a1[1], bf_lo(gv.w) * a1[2], bf_hi(gv.w) * a1[3]};
                        bf16_t* tp = T + r * ldc + col0 + bj * HALF;
                        if (ADD) { const u32x4 tv = tvv[mm][bj];
                            o[0] += bf_lo(tv.x); o[1] += bf_hi(tv.x); o[2] += bf_lo(tv.y); o[3] += bf_hi(tv.y); o[4] += bf_lo(tv.z); o[5] += bf_hi(tv.z); o[6] += bf_lo(tv.w); o[7] += bf_hi(tv.w); }
                        u32x4 w; w.x = cvt_pk_bf16(o[0], o[1]); w.y = cvt_pk_bf16(o[2], o[3]); w.z = cvt_pk_bf16(o[4], o[5]); w.w = cvt_pk_bf16(o[6], o[7]);
                        *(u32x4*)tp = w;
                    }
                }
            }
    }
};
template <class Epi, class Sched, bool ALIGN_EPI = false, bool SP2 = false>
__device__ __forceinline__ void gemm_phase(PG8_LAS unsigned char* lds, const Gemm g, const Sched& S, const Epi& E) {
    const int tid = threadIdx.x, wid = __builtin_amdgcn_readfirstlane(tid >> 6), lane = tid & 63, wr = wid >> 2, wc = wid & 3, fr = lane & 15, fq = lane >> 4;
    const int K = g.K, nt = K / BK, LDA = g.lda ? g.lda : K, LDB = g.ldb ? g.ldb : K;
    unsigned voffA[2], voffB[2];
#pragma unroll
    for (int i = 0; i < 2; ++i) { int R, C; stage_rc(tid * 16 + i * 8192, R, C); const int Rb = Epi::PERM ? ((R & ~31) + perm32(R & 31)) : R;
        voffA[i] = (unsigned)(R * LDA + C) * 2u; voffB[i] = (unsigned)(Rb * LDB + C) * 2u; }
    const size_t kstep = (size_t)(BK * 2);
    const size_t hstepA = (size_t)HALF * LDA * 2, hstepB = (size_t)HALF * LDB * 2;
    const size_t tstepA = 2 * hstepA, tstepB = 2 * hstepB;
    const unsigned ldsw = (unsigned)wid * 1024u;
    const int aoff = lds_byte(wr * 64 + fr, fq * 8), boff = lds_byte(wc * 32 + fr, fq * 8);
#define PG8_SA(b, h) (((b) * 2 + (h)) * HTB)
#define PG8_SB(b, h) ((4 + (b) * 2 + (h)) * HTB)
#define PG8_STAGE(bufoff, gbase, voff) do { _Pragma("unroll") for (int _i = 0; _i < 2; ++_i) \
        __builtin_amdgcn_global_load_lds((const unsigned*)((const char*)(gbase) + (voff)[_i]), (PG8_LAS unsigned*)(lds + (bufoff) + ldsw + _i * 8192), 16, 0, 0); } while (0)
#define PG8_LDA(dst, b, h) do { _Pragma("unroll") for (int m = 0; m < 4; ++m) _Pragma("unroll") for (int k = 0; k < 2; ++k) dst[m][k] = *(const PG8_LAS bf16x8*)(lds + PG8_SA(b, h) + aoff + m * 2048 + k * 1024); } while (0)
#define PG8_LDB(dst, b, h) do { _Pragma("unroll") for (int n = 0; n < 2; ++n) _Pragma("unroll") for (int k = 0; k < 2; ++k) dst[n][k] = *(const PG8_LAS bf16x8*)(lds + PG8_SB(b, h) + boff + n * 2048 + k * 1024); } while (0)
#define PG8_MMA(ai, bj, At, Bt) do { __builtin_amdgcn_s_setprio(1); _Pragma("unroll") for (int m = 0; m < 4; ++m) _Pragma("unroll") for (int n = 0; n < 2; ++n) _Pragma("unroll") for (int k = 0; k < 2; ++k) \
        acc[ai][bj][m][n] = __builtin_amdgcn_mfma_f32_16x16x32_bf16(Bt[n][k], At[m][k], acc[ai][bj][m][n], 0, 0, 0); __builtin_amdgcn_s_setprio(0); } while (0)
#define PG8_WAIT_V(n) asm volatile("s_waitcnt vmcnt(" #n ")" ::: "memory")
#define PG8_WAIT_L(n) asm volatile("s_waitcnt lgkmcnt(" #n ")" ::: "memory")
#define PG8_BAR __builtin_amdgcn_s_barrier()
#define PG8_SCHED __builtin_amdgcn_sched_barrier(0)
    Unit cur, nxt; int ui = 0;
    if (!S.next(0, cur)) return;
    f32x4 acc[2][2][4][2];
#pragma unroll
    for (int a = 0; a < 2; ++a)
#pragma unroll
        for (int b = 0; b < 2; ++b)
#pragma unroll
            for (int m = 0; m < 4; ++m)
#pragma unroll
                for (int n = 0; n < 2; ++n) acc[a][b][m][n] = (f32x4){0.f, 0.f, 0.f, 0.f};
    bf16x8 At[4][2], B0[2][2], B1[2][2];
    const char* cA = (const char*)g.A + (size_t)cur.pm * tstepA; const char* cB = (const char*)g.Bt + (size_t)cur.pn * tstepB;
    S.a_ready(cur);
    if constexpr (SP2) {
        PG8_STAGE(PG8_SB(0, 0), cB, voffB); PG8_STAGE(PG8_SB(0, 1), cB + hstepB, voffB); PG8_STAGE(PG8_SA(0, 0), cA, voffA); PG8_STAGE(PG8_SA(0, 1), cA + hstepA, voffA);
        if (wr == 1) PG8_BAR;
        PG8_WAIT_V(2); PG8_BAR;
        PG8_STAGE(PG8_SB(1, 0), cB + kstep, voffB); PG8_STAGE(PG8_SA(1, 0), cA + kstep, voffA); PG8_STAGE(PG8_SB(1, 1), cB + hstepB + kstep, voffB);
        PG8_WAIT_V(6); PG8_BAR;
    } else {
        PG8_STAGE(PG8_SB(0, 0), cB, voffB); PG8_STAGE(PG8_SA(0, 0), cA, voffA); PG8_STAGE(PG8_SB(0, 1), cB + hstepB, voffB); PG8_STAGE(PG8_SA(0, 1), cA + hstepA, voffA);
        if (wr == 1) PG8_BAR;
        PG8_WAIT_V(4); PG8_BAR;
        PG8_STAGE(PG8_SB(1, 0), cB + kstep, voffB); PG8_STAGE(PG8_SA(1, 0), cA + kstep, voffA); PG8_STAGE(PG8_SB(1, 1), cB + hstepB + kstep, voffB);
        PG8_WAIT_V(6); PG8_BAR;
    }
    for (;;) {
        const bool has_next = S.next(ui + 1, nxt);
        const char* nA = has_next ? (const char*)g.A + (size_t)nxt.pm * tstepA : cA; const char* nB = has_next ? (const char*)g.Bt + (size_t)nxt.pn * tstepB : cB;
        for (int t = 0; t < nt; t += 2) {
            const bool last = (t == nt - 2);
            const char* a1 = cA + (size_t)(t + 1) * kstep;
            const char* a2 = last ? nA : cA + (size_t)(t + 2) * kstep; const char* b2 = last ? nB : cB + (size_t)(t + 2) * kstep;
            const char* a3 = a2 + kstep; const char* b3 = b2 + kstep;
            if (last && has_next) S.a_ready(nxt);
            if constexpr (SP2) {
            PG8_LDB(B0, 0, 0); PG8_LDB(B1, 0, 1); PG8_SCHED; PG8_LDA(At, 0, 0); PG8_STAGE(PG8_SA(1, 1), a1 + hstepA, voffA);
            PG8_WAIT_V(8); PG8_WAIT_L(0); PG8_BAR; PG8_MMA(0, 0, At, B0); PG8_MMA(0, 1, At, B1); PG8_BAR; PG8_SCHED;
            PG8_LDA(At, 0, 1); PG8_STAGE(PG8_SB(0, 0), b2, voffB); PG8_STAGE(PG8_SB(0, 1), b2 + hstepB, voffB); PG8_STAGE(PG8_SA(0, 0), a2, voffA);
            PG8_WAIT_V(8); PG8_WAIT_L(0); PG8_BAR; PG8_MMA(1, 0, At, B0); PG8_MMA(1, 1, At, B1); PG8_BAR; PG8_SCHED;
            PG8_LDB(B0, 1, 0); PG8_LDB(B1, 1, 1); PG8_SCHED; PG8_LDA(At, 1, 0); PG8_STAGE(PG8_SA(0, 1), a2 + hstepA, voffA);
            PG8_WAIT_V(8); PG8_WAIT_L(0); PG8_BAR; PG8_MMA(0, 0, At, B0); PG8_MMA(0, 1, At, B1); PG8_BAR; PG8_SCHED;
            PG8_LDA(At, 1, 1); PG8_STAGE(PG8_SB(1, 0), b3, voffB); PG8_STAGE(PG8_SB(1, 1), b3 + hstepB, voffB); PG8_STAGE(PG8_SA(1, 0), a3, voffA);
            PG8_WAIT_V(8); PG8_WAIT_L(0); PG8_BAR; PG8_MMA(1, 0, At, B0); PG8_MMA(1, 1, At, B1); PG8_BAR; PG8_SCHED;
            } else {
            PG8_LDB(B0, 0, 0); PG8_SCHED; PG8_LDA(At, 0, 0); PG8_STAGE(PG8_SA(1, 1), a1 + hstepA, voffA);
            PG8_WAIT_L(8); PG8_BAR; PG8_WAIT_L(0); PG8_MMA(0, 0, At, B0); PG8_BAR; PG8_SCHED;
            PG8_LDB(B1, 0, 1); PG8_STAGE(PG8_SB(0, 0), b2, voffB);
            PG8_BAR; PG8_WAIT_L(0); PG8_MMA(0, 1, At, B1); PG8_BAR;
            PG8_LDA(At, 0, 1); PG8_STAGE(PG8_SA(0, 0), a2, voffA);
            PG8_BAR; PG8_WAIT_L(0); PG8_MMA(1, 0, At, B0); PG8_BAR; PG8_SCHED;
            PG8_STAGE(PG8_SB(0, 1), b2 + hstepB, voffB);
            PG8_WAIT_V(6); PG8_BAR; PG8_MMA(1, 1, At, B1); PG8_BAR;
            PG8_LDB(B0, 1, 0); PG8_SCHED; PG8_LDA(At, 1, 0); PG8_STAGE(PG8_SA(0, 1), a2 + hstepA, voffA);
            PG8_WAIT_L(8); PG8_BAR; PG8_WAIT_L(0); PG8_MMA(0, 0, At, B0); PG8_BAR; PG8_SCHED;
            PG8_LDB(B1, 1, 1); PG8_STAGE(PG8_SB(1, 0), b3, voffB);
            PG8_BAR; PG8_WAIT_L(0); PG8_MMA(0, 1, At, B1); PG8_BAR;
            PG8_LDA(At, 1, 1); PG8_STAGE(PG8_SA(1, 0), a3, voffA);
            PG8_BAR; PG8_WAIT_L(0); PG8_MMA(1, 0, At, B0); PG8_BAR; PG8_SCHED;
            PG8_STAGE(PG8_SB(1, 1), b3 + hstepB, voffB);
            PG8_WAIT_V(6); PG8_BAR; PG8_MMA(1, 1, At, B1); PG8_BAR;
            }
        }
        if constexpr (ALIGN_EPI) { if (wr == 0) PG8_BAR; }
        if constexpr (!Epi::AFTER_DRAIN) { E(acc, cur, wr, wc, fr, fq); S.done(cur); }
        if (!has_next) break;
#pragma unroll
        for (int a = 0; a < 2; ++a)
#pragma unroll
            for (int b = 0; b < 2; ++b)
#pragma unroll
                for (int m = 0; m < 4; ++m)
#pragma unroll
                    for (int n = 0; n < 2; ++n) acc[a][b][m][n] = (f32x4){0.f, 0.f, 0.f, 0.f};
        cur = nxt; cA = nA; cB = nB; ++ui;
        if constexpr (ALIGN_EPI) { if (wr == 1) PG8_BAR; }
    }
    PG8_WAIT_V(0);
    if constexpr (!ALIGN_EPI) { if (wr == 0) PG8_BAR; }
    PG8_BAR;
    if constexpr (Epi::AFTER_DRAIN) { E.fused(acc, cur, wr, wc, fr, fq, lds, wid, lane); S.done(cur); }
#undef PG8_SA
#undef PG8_SB
#undef PG8_STAGE
#undef PG8_LDA
#undef PG8_LDB
#undef PG8_MMA
#undef PG8_WAIT_V
#undef PG8_WAIT_L
#undef PG8_BAR
#undef PG8_SCHED
}
}
constexpr int M = 8192, D = 2048, FF = 5632, SEQ = 4096, NUP = 2 * FF, D_IN = 10704;
constexpr int PW = 10752;
constexpr int PQ = 0, PK = 512, PV = 1024, PR = 2048;
constexpr int RR = 3072, RK = 4096, RV = 5120;
constexpr int GG = 6144, GR = 8192;
constexpr int SM = 10240;
constexpr int NLORA = 3072, KLORA = 512;
constexpr size_t MiB = 1u << 20;
constexpr size_t WS_WUP = 1 * MiB, WS_WDN = 45 * MiB, WS_WIN = 67 * MiB, WS_WBR1 = 109 * MiB, WS_WBR2 = 113 * MiB, WS_WOUT = 117 * MiB, WS_WLORA = 125 * MiB;
constexpr size_t WS_H = 128 * MiB, WS_X1 = 160 * MiB, WS_P = 224 * MiB, WS_LORA = 392 * MiB, WS_END = 440 * MiB;
constexpr size_t WS_ALORA = WS_H, WS_GTOT = WS_H + 8 * MiB, WS_OGLA = WS_H + 16 * MiB;
constexpr size_t WS_Y = WS_WIN;
constexpr size_t WS_ACT = WS_P;
constexpr size_t OUT_STATE = 0, OUT_ORW = 0, OUT_T = 16 * MiB;
constexpr size_t WS_SS1 = 0, WS_SS2 = 65536, WS_SS3 = 98304;
constexpr size_t WS_ORW = 1 * MiB, WS_T = 17 * MiB, WS_WDN2 = 49 * MiB;
constexpr int LDS_BYTES = 147456;

#define LAS __attribute__((address_space(3)))
typedef unsigned short bf16;
typedef unsigned v4u __attribute__((ext_vector_type(4)));
typedef unsigned v2u __attribute__((ext_vector_type(2)));
typedef float f32x4 __attribute__((ext_vector_type(4)));
typedef float f32x2 __attribute__((ext_vector_type(2)));
typedef short bf16x8 __attribute__((ext_vector_type(8)));
#define LDS_WAIT() asm volatile("s_waitcnt lgkmcnt(0)" ::: "memory")
__device__ __forceinline__ unsigned f2bf(float f) { unsigned u = __builtin_bit_cast(unsigned, f); return (u + 0x7fffu + ((u >> 16) & 1u)) >> 16; }
__device__ __forceinline__ unsigned pk2(float lo, float hi) { return f2bf(lo) | (f2bf(hi) << 16); }
__device__ __forceinline__ float bflo(unsigned u) { return __uint_as_float(u << 16); }
__device__ __forceinline__ float bfhi(unsigned u) { return __uint_as_float(u & 0xffff0000u); }
__device__ __forceinline__ float bf1(bf16 u) { return __uint_as_float((unsigned)u << 16); }
__device__ __forceinline__ float sigmoidf_(float x) { return __builtin_amdgcn_rcpf(1.0f + __builtin_amdgcn_exp2f(-1.4426950408889634f * x)); }
__device__ __forceinline__ float wave_sum(float v) {
#pragma unroll
    for (int o = 1; o < 64; o <<= 1) v += __shfl_xor(v, o);
    return v;
}
template <int CTRL> __device__ __forceinline__ float dppf(float v) { return __builtin_bit_cast(float, __builtin_amdgcn_update_dpp(0, __builtin_bit_cast(int, v), CTRL, 0xF, 0xF, true)); }
__device__ __forceinline__ float allred8(float v) { v += dppf<0xB1>(v); v += dppf<0x4E>(v); v += dppf<0x141>(v); return v; }
__device__ __forceinline__ float allred16(float v) { v = allred8(v); v += dppf<0x140>(v); return v; }

#define XB_TMO      128
#define XB_XCNT(j)  (256  + 64 * (j))
#define XB_XSUB(j)  (1280 + 64 * (j))
#define XB_XGEN(j)  (2304 + 64 * (j))
#define XB_TOP      3328
#define XB_TOPGEN   3392
#define XCD_BAR_WORDS 3456
#define XB_SPIN_CAP (1u << 18)

__device__ __forceinline__ unsigned xb_ld(unsigned* p)              { return __hip_atomic_load(p, __ATOMIC_RELAXED, __HIP_MEMORY_SCOPE_AGENT); }
__device__ __forceinline__ unsigned xb_add(unsigned* p, unsigned v) { return __hip_atomic_fetch_add(p, v, __ATOMIC_RELAXED, __HIP_MEMORY_SCOPE_AGENT); }
__device__ __forceinline__ unsigned xb_xcc_id() { return (unsigned)__builtin_amdgcn_s_getreg((3 << 11) | 20) & 0xFu; }
#define XB_SPIN(cond, bar) do { unsigned _sp = 0; while (cond) { __builtin_amdgcn_s_sleep(1); \
    if ((++_sp & 255u) == 0u) { if (xb_ld(&(bar)[XB_TMO])) break; if (_sp > XB_SPIN_CAP) { atomicAdd(&(bar)[XB_TMO], 1u); break; } } } } while (0)

struct XcdBarrier {
    unsigned* bar; unsigned x;
    volatile LAS unsigned* st;
};

__device__ __forceinline__ XcdBarrier xcd_barrier_post(unsigned* bar, volatile LAS unsigned* st) {
    XcdBarrier b; b.bar = bar; b.x = xb_xcc_id(); b.st = st;
    if (threadIdx.x == 0) (void)xb_add(&bar[XB_XCNT(b.x)], 1u);
    return b;
}
__device__ __forceinline__ void xcd_barrier_complete(unsigned* bar, unsigned x, unsigned& nloc, unsigned& nx) {
    const unsigned G = gridDim.x * gridDim.y * gridDim.z;
    unsigned sum, cnt, mine, sp = 0u;
    for (;;) {
        sum = 0u; cnt = 0u; mine = 0u;
#pragma unroll
        for (unsigned j = 0; j < 16; ++j) { const unsigned c = xb_ld(&bar[XB_XCNT(j)]); sum += c; cnt += (c > 0u) ? 1u : 0u; mine = (j == x) ? c : mine; }
        if (sum == G) break;
        __builtin_amdgcn_s_sleep(1);
        if ((++sp & 255u) == 0u) { if (xb_ld(&bar[XB_TMO])) break; if (sp > XB_SPIN_CAP) { atomicAdd(&bar[XB_TMO], 1u); break; } }
    }
    nloc = mine > 0u ? mine : 1u; nx = cnt > 0u ? cnt : 1u;
}

__device__ __forceinline__ void xcd_barrier(const XcdBarrier& b) {
    asm volatile("s_waitcnt vmcnt(0)" ::: "memory");
    __syncthreads();
    if (threadIdx.x == 0) {
        unsigned* bar = b.bar;
        __builtin_amdgcn_s_waitcnt(0);
        unsigned nloc = b.st[0], nx = b.st[1];
        if (nloc == 0u) { xcd_barrier_complete(bar, b.x, nloc, nx); b.st[0] = nloc; b.st[1] = nx; }
        const unsigned old = xb_add(&bar[XB_XSUB(b.x)], 1u);
        const unsigned gen = old / nloc;
        if (old + 1u == (gen + 1u) * nloc) {
            __builtin_amdgcn_fence(__ATOMIC_RELEASE, "agent");
            asm volatile("s_waitcnt vmcnt(0)" ::: "memory");
            const unsigned og = xb_add(&bar[XB_TOP], 1u);
            const unsigned tg = og / nx;
            if (og + 1u == (tg + 1u) * nx) xb_add(&bar[XB_TOPGEN], 1u);
            else XB_SPIN(xb_ld(&bar[XB_TOPGEN]) == tg, bar);
            __builtin_amdgcn_fence(__ATOMIC_ACQUIRE, "agent");
            xb_add(&bar[XB_XGEN(b.x)], 1u);
            asm volatile("s_waitcnt vmcnt(0)" ::: "memory");
        } else {
            XB_SPIN(xb_ld(&bar[XB_XGEN(b.x)]) == gen, bar);
            __builtin_amdgcn_fence(__ATOMIC_ACQUIRE, "agent");
            asm volatile("s_waitcnt vmcnt(0)" ::: "memory");
        }
    }
    __syncthreads();
}

struct EpiFinalBar {
    static constexpr bool PERM = true, AFTER_DRAIN = true;
    const float* base; float* out; int ldc; float scale; const float* gn; float* ss; XcdBarrier bar;
    __device__ __forceinline__ void operator()(const pg8::f32x4 (&)[2][2][4][2], const pg8::Unit&, int, int, int, int) const {}
    __device__ __forceinline__ void fused(pg8::f32x4 (&acc)[2][2][4][2], const pg8::Unit& u, int wr, int wc, int fr, int fq, LAS unsigned char*, int, int) const {
        using pg8::BM; using pg8::HALF; typedef pg8::f32x4 f4;
        const int row0 = u.pm * BM + wr * 64 + fr, col0 = u.pn * BM + wc * 32 + 8 * fq;
#pragma unroll
        for (int ai = 0; ai < 2; ++ai)
#pragma unroll
            for (int m = 0; m < 4; ++m) {
                const size_t off = (size_t)(row0 + ai * HALF + m * 16) * ldc + col0; float sq = 0.f;
#pragma unroll
                for (int bj = 0; bj < 2; ++bj) { const f4 b0 = *(const f4*)(base + off + bj * HALF), b1 = *(const f4*)(base + off + bj * HALF + 4);
                    const f4 o0 = b0 + acc[ai][bj][m][0] * scale, o1 = b1 + acc[ai][bj][m][1] * scale; acc[ai][bj][m][0] = o0; acc[ai][bj][m][1] = o1;
                    sq += (o0[0] * o0[0] + o0[1] * o0[1]) + (o0[2] * o0[2] + o0[3] * o0[3]) + (o1[0] * o1[0] + o1[1] * o1[1]) + (o1[2] * o1[2] + o1[3] * o1[3]); }
                sq += __shfl_xor(sq, 16); sq += __shfl_xor(sq, 32); if (fq == 0) atomicAdd(ss + row0 + ai * HALF + m * 16, sq);
            }
        xcd_barrier(bar);
        f4 gv[2][2];
#pragma unroll
        for (int bj = 0; bj < 2; ++bj) { gv[bj][0] = *(const f4*)(gn + col0 + bj * HALF); gv[bj][1] = *(const f4*)(gn + col0 + bj * HALF + 4); }
#pragma unroll
        for (int ai = 0; ai < 2; ++ai)
#pragma unroll
            for (int m = 0; m < 4; ++m) { const int r = row0 + ai * HALF + m * 16; const float rs = rsqrtf(__hip_atomic_load(ss + r, __ATOMIC_RELAXED, __HIP_MEMORY_SCOPE_AGENT) * (1.0f / 2048.0f) + 1e-6f); const size_t off = (size_t)r * ldc + col0;
#pragma unroll
                for (int bj = 0; bj < 2; ++bj) { *(f4*)(out + off + bj * HALF) = acc[ai][bj][m][0] * rs * gv[bj][0]; *(f4*)(out + off + bj * HALF + 4) = acc[ai][bj][m][1] * rs * gv[bj][1]; } }
    }
};

constexpr size_t WS_BAR = 262144;
struct Frame {
    LAS unsigned char* lds;
    int tid, lane, wave, gw, NGW, G;
    const float* in[29]; float* out; unsigned char* ws;
};
enum { I_X = 0, I_N1, I_WG1, I_WU1, I_WD1, I_NMIX, I_WIN, I_GLA_WA2, I_GLA_BA, I_GLA_GN, I_MU, I_W0, I_WW2, I_A0, I_WA2, I_WG2, I_KK, I_KA, I_RK, I_LNW, I_LNB, I_GATEB, I_WBR, I_WOUT, I_N2, I_WG2F, I_WU2F, I_WD2F, I_NF };

template <class F> __device__ __forceinline__ void tr_item(const F& srcf, int ldw, bf16* WT, int Kd, int kb, int nb, LAS float* scr, int lane) {
    const int k0 = 64 * kb, n0 = 32 * nb;
    const int kr = lane >> 3, n4 = lane & 7;
    const float* p = srcf(n0 + 4 * n4);
#pragma unroll
    for (int i = 0; i < 8; ++i) { const int kk = 8 * i + kr; const f32x4 v = p ? *(const f32x4*)(p + (size_t)(k0 + kk) * ldw) : (f32x4){0.f, 0.f, 0.f, 0.f};
        LAS float* d = scr + kk * 33 + 4 * n4; d[0] = v.x; d[1] = v.y; d[2] = v.z; d[3] = v.w; }
    LDS_WAIT(); asm volatile("" ::: "memory");
    const int c = lane & 7;
#pragma unroll
    for (int j = 0; j < 4; ++j) { const int n = (lane >> 3) + 8 * j; const LAS float* s = scr + (8 * c) * 33 + n;
        v4u o; o.x = pk2(s[0 * 33], s[1 * 33]); o.y = pk2(s[2 * 33], s[3 * 33]); o.z = pk2(s[4 * 33], s[5 * 33]); o.w = pk2(s[6 * 33], s[7 * 33]);
        *(v4u*)(WT + (size_t)(n0 + n) * Kd + k0 + 8 * c) = o; }
    LDS_WAIT(); asm volatile("" ::: "memory");
}
template <class F> __device__ __forceinline__ void tr_job(const Frame& F_, const F& srcf, int ldw, bf16* WT, int Ksrc, int Ndest, int w0, int nw) {
    LAS float* scr = (LAS float*)(F_.lds + F_.wave * 8448);
    const int nblk = Ndest / 32, items = (Ksrc / 64) * nblk;
    for (int it = w0; it < items; it += nw) tr_item(srcf, ldw, WT, Ksrc, it / nblk, it % nblk, scr, F_.lane);
}
struct SrcUp { const float* wg; const float* wu; __device__ __forceinline__ const float* operator()(int n) const { const int t = n >> 8, w = n & 255; return (w < 128) ? wg + 128 * t + w : wu + 128 * t + (w - 128); } };
struct SrcPlain { const float* w; __device__ __forceinline__ const float* operator()(int n) const { return w + n; } };
struct SrcWin { const float* w; __device__ __forceinline__ const float* operator()(int c) const {
    int s;
    if (c < 3072) s = c; else if (c < 6144) s = c + 16; else if (c < 10240) s = c + 464;
    else { const int j = c - 10240; if (j < 16) s = 3072 + j; else if (j < 32) s = -1; else if (j < 128) s = 6160 + (j - 32); else if (j < 224) s = 6256 + (j - 128); else if (j < 256) s = -1; else s = 6352 + (j - 256); }
    return s < 0 ? nullptr : w + s; } };
__device__ __forceinline__ void convert_ffn_up(const Frame& F, int l, bf16* dst, int w0, int nw) { tr_job(F, SrcUp{F.in[l ? I_WG2F : I_WG1], F.in[l ? I_WU2F : I_WU1]}, FF, dst, D, NUP, w0, nw); }
__device__ __forceinline__ void convert_ffn_dn(const Frame& F, int l, bf16* dst, int w0, int nw) { tr_job(F, SrcPlain{F.in[l ? I_WD2F : I_WD1]}, D, dst, FF, D, w0, nw); }
__device__ __forceinline__ void convert_ffn(const Frame& F, int l, int w0, int nw) { convert_ffn_up(F, l, (bf16*)(F.ws + WS_WUP), w0, nw); convert_ffn_dn(F, l, (bf16*)(F.ws + WS_WDN), w0, nw); }
__device__ __forceinline__ void norm_rows_bf16(const Frame& F, const float* X, const float* g, bf16* H) {
    for (int m = F.gw; m < M; m += 2 * F.NGW) {
        const int m2 = (m + F.NGW < M) ? m + F.NGW : m;
        const f32x4* xa = (const f32x4*)(X + (size_t)m * D) + F.lane; const f32x4* xb = (const f32x4*)(X + (size_t)m2 * D) + F.lane; f32x4 va[8], vb[8]; float sa = 0.f, sb = 0.f;
#pragma unroll
        for (int j = 0; j < 8; ++j) { va[j] = xa[64 * j]; vb[j] = xb[64 * j]; }
#pragma unroll
        for (int j = 0; j < 8; ++j) { sa += (va[j].x * va[j].x + va[j].y * va[j].y) + (va[j].z * va[j].z + va[j].w * va[j].w); sb += (vb[j].x * vb[j].x + vb[j].y * vb[j].y) + (vb[j].z * vb[j].z + vb[j].w * vb[j].w); }
        const float ra = rsqrtf(wave_sum(sa) * (1.0f / D) + 1e-6f), rb = rsqrtf(wave_sum(sb) * (1.0f / D) + 1e-6f);
        v2u* oa = (v2u*)(H + (size_t)m * D) + F.lane; v2u* ob = (v2u*)(H + (size_t)m2 * D) + F.lane;
#pragma unroll
        for (int j = 0; j < 8; ++j) { const f32x4 gv = ((const f32x4*)g)[F.lane + 64 * j];
            v2u o; o.x = pk2(va[j].x * ra * gv.x, va[j].y * ra * gv.y); o.y = pk2(va[j].z * ra * gv.z, va[j].w * ra * gv.w); oa[64 * j] = o;
            o.x = pk2(vb[j].x * rb * gv.x, vb[j].y * rb * gv.y); o.y = pk2(vb[j].z * rb * gv.z, vb[j].w * rb * gv.w); ob[64 * j] = o; }
    }
}
__device__ __forceinline__ void final_norm(const Frame& F, float* X, const float* g) {
    for (int m = F.gw; m < M; m += 2 * F.NGW) {
        const int m2 = (m + F.NGW < M) ? m + F.NGW : m;
        f32x4* xa = (f32x4*)(X + (size_t)m * D) + F.lane; f32x4* xb = (f32x4*)(X + (size_t)m2 * D) + F.lane; f32x4 va[8], vb[8]; float sa = 0.f, sb = 0.f;
#pragma unroll
        for (int j = 0; j < 8; ++j) { va[j] = xa[64 * j]; vb[j] = xb[64 * j]; }
#pragma unroll
        for (int j = 0; j < 8; ++j) { sa += (va[j].x * va[j].x + va[j].y * va[j].y) + (va[j].z * va[j].z + va[j].w * va[j].w); sb += (vb[j].x * vb[j].x + vb[j].y * vb[j].y) + (vb[j].z * vb[j].z + vb[j].w * vb[j].w); }
        const float ra = rsqrtf(wave_sum(sa) * (1.0f / D) + 1e-6f), rb = rsqrtf(wave_sum(sb) * (1.0f / D) + 1e-6f);
#pragma unroll
        for (int j = 0; j < 8; ++j) { const f32x4 gv = ((const f32x4*)g)[F.lane + 64 * j]; xa[64 * j] = va[j] * ra * gv; if (m2 != m) xb[64 * j] = vb[j] * rb * gv; }
    }
}
__device__ __forceinline__ void final_scale(const Frame& F, const bf16* XB, const float* ss, float* out) {
    for (int m = F.gw; m < M; m += F.NGW) {
        const float rstd = rsqrtf(ss[m] * (1.0f / D) + 1e-6f);
        const v4u* xr = (const v4u*)(XB + (size_t)m * D) + F.lane; f32x4* o = (f32x4*)(out + (size_t)m * D) + 2 * F.lane; v4u v[4];
#pragma unroll
        for (int j = 0; j < 4; ++j) v[j] = xr[64 * j];
#pragma unroll
        for (int j = 0; j < 4; ++j) { o[128 * j] = (f32x4){bflo(v[j].x), bfhi(v[j].x), bflo(v[j].y), bfhi(v[j].y)} * rstd; o[128 * j + 1] = (f32x4){bflo(v[j].z), bfhi(v[j].z), bflo(v[j].w), bfhi(v[j].w)} * rstd; }
    }
}
__device__ __forceinline__ void p_prologue(const Frame& F) {
    convert_ffn_up(F, 0, (bf16*)(F.ws + WS_WUP), F.gw, F.NGW);
    { unsigned* WL = (unsigned*)(F.ws + WS_WLORA); const int gt = F.gw * 64 + F.lane, GT = F.NGW * 64;
      for (int i = gt; i < NLORA * 128; i += GT) { const int n = i >> 7, k = (i & 127) * 2; float v0 = 0.f, v1 = 0.f;
          if (n < 1024) { if (k >= 32 && k < 128) { v0 = F.in[I_WW2][(size_t)(k - 32) * 1024 + n]; v1 = F.in[I_WW2][(size_t)(k - 31) * 1024 + n]; } }
          else if (n < 2048) { if (k >= 128 && k < 224) { v0 = F.in[I_WA2][(size_t)(k - 128) * 1024 + n - 1024]; v1 = F.in[I_WA2][(size_t)(k - 127) * 1024 + n - 1024]; } }
          else { v0 = F.in[I_WG2][(size_t)k * 1024 + n - 2048]; v1 = F.in[I_WG2][(size_t)(k + 1) * 1024 + n - 2048]; }
          WL[i] = pk2(v0, v1); } }
    norm_rows_bf16(F, F.in[I_X], F.in[I_N1], (bf16*)(F.ws + WS_H));
    { float* z = (float*)(F.ws + WS_SS1); for (int i = F.gw * 64 + F.lane; i < 2 * 16384; i += F.NGW * 64) z[i] = 0.f; }
}
__device__ __forceinline__ void p_lora_a(const Frame& F) {
    const bf16* P = (const bf16*)(F.ws + WS_P); bf16* A = (bf16*)(F.ws + WS_ALORA); const float* mu = F.in[I_MU];
    const int j0 = 8 * F.lane;
    int kind, mi;
    if (j0 < 32) { kind = 0; mi = 0; } else if (j0 < 128) { kind = 1; mi = 3072 + j0 - 32; } else if (j0 < 224) { kind = 2; mi = 3168 + j0 - 128; } else if (j0 < 256) { kind = 0; mi = 0; } else { kind = 3; mi = 3264 + j0 - 256; }
    float muv[8];
#pragma unroll
    for (int j = 0; j < 8; ++j) muv[j] = kind ? mu[mi + j] : 0.f;
    for (int m = F.gw; m < M; m += F.NGW) {
        const bool first = (m % SEQ) == 0;
        const v4u c = *(const v4u*)(P + (size_t)m * PW + SM + j0);
        v4u p = *(const v4u*)(P + (size_t)(first ? m : m - 1) * PW + SM + j0);
        if (first) p = (v4u){0u, 0u, 0u, 0u};
        float cv[8] = {bflo(c.x), bfhi(c.x), bflo(c.y), bfhi(c.y), bflo(c.z), bfhi(c.z), bflo(c.w), bfhi(c.w)};
        float pv[8] = {bflo(p.x), bfhi(p.x), bflo(p.y), bfhi(p.y), bflo(p.z), bfhi(p.z), bflo(p.w), bfhi(p.w)};
        float o[8];
#pragma unroll
        for (int j = 0; j < 8; ++j) { const float s = cv[j] + muv[j] * (pv[j] - cv[j]);
            o[j] = kind == 0 ? 0.f : kind == 1 ? (1.0f - 2.0f * __builtin_amdgcn_rcpf(1.0f + __builtin_amdgcn_exp2f(2.885390081777927f * s))) : kind == 2 ? s : sigmoidf_(s); }
        v4u w; w.x = pk2(o[0], o[1]); w.y = pk2(o[2], o[3]); w.z = pk2(o[4], o[5]); w.w = pk2(o[6], o[7]);
        *(v4u*)(A + (j0 < 256 ? (size_t)m * 256 + j0 : (size_t)M * 256 + (size_t)m * 256 + (j0 - 256))) = w;
    }
}
__device__ __forceinline__ float log_sigmoid_(float z) { return fminf(z, 0.f) - __logf(1.0f + __expf(-fabsf(z))); }
__device__ __forceinline__ void gla_u_unit(const Frame& F, int unit) {
    const int b = unit >> 8, n = (unit >> 2) & 63, h = unit & 3, tid = F.tid;
    const bf16* P = (const bf16*)(F.ws + WS_P); const size_t row0 = (size_t)b * SEQ + (size_t)n * 64;
    LAS float* adS = (LAS float*)F.lds;
    LAS float* qtot = (LAS float*)(F.lds + 4096);
    LAS bf16* kdT = (LAS bf16*)(F.lds + 8192);
    LAS bf16* vT = (LAS bf16*)(F.lds + 8192 + 18432);
    if (tid < 128) { const int c = tid >> 1, hf = tid & 1; const v4u a = *(const v4u*)(P + (row0 + c) * PW + SM + 8 * hf);
        LAS float* d = adS + c * 16 + 8 * hf; d[0] = bflo(a.x); d[1] = bfhi(a.x); d[2] = bflo(a.y); d[3] = bfhi(a.y); d[4] = bflo(a.z); d[5] = bfhi(a.z); d[6] = bflo(a.w); d[7] = bfhi(a.w); }
    const int k = tid & 127, q = tid >> 7;
    float wa[16];
#pragma unroll
    for (int j = 0; j < 16; ++j) wa[j] = F.in[I_GLA_WA2][j * 512 + h * 128 + k];
    const float ba = F.in[I_GLA_BA][h * 128 + k];
#pragma unroll
    for (int i = 0; i < 4; ++i) { const int idx = tid + 512 * i, c = idx & 63, v8 = idx >> 6; const v4u vv = *(const v4u*)(P + (row0 + c) * PW + PV + h * 256 + 8 * v8);
        LAS bf16* d = vT + (8 * v8) * 72 + c; d[0] = (bf16)(vv.x & 0xffff); d[72] = (bf16)(vv.x >> 16); d[144] = (bf16)(vv.y & 0xffff); d[216] = (bf16)(vv.y >> 16);
        d[288] = (bf16)(vv.z & 0xffff); d[360] = (bf16)(vv.z >> 16); d[432] = (bf16)(vv.w & 0xffff); d[504] = (bf16)(vv.w >> 16); }
    __syncthreads();
    float cum[16]; float run = 0.f;
#pragma unroll
    for (int ci = 0; ci < 16; ++ci) { const LAS f32x4* ar = (const LAS f32x4*)(adS + (16 * q + ci) * 16); float z = ba;
#pragma unroll
        for (int j4 = 0; j4 < 4; ++j4) { const f32x4 a = ar[j4]; z += a.x * wa[4 * j4] + a.y * wa[4 * j4 + 1] + a.z * wa[4 * j4 + 2] + a.w * wa[4 * j4 + 3]; }
        run += log_sigmoid_(z) * (1.0f / 16.0f); cum[ci] = run; }
    qtot[q * 128 + k] = run;
    __syncthreads();
    float off = 0.f, tot = 0.f;
#pragma unroll
    for (int qq = 0; qq < 4; ++qq) { const float t = qtot[qq * 128 + k]; tot += t; if (qq < q) off += t; }
#pragma unroll
    for (int ci = 0; ci < 16; ++ci) { const int c = 16 * q + ci; const float kf = bf1(P[(row0 + c) * PW + PK + h * 128 + k]);
        kdT[k * 72 + c] = (bf16)f2bf(kf * __expf(tot - (off + cum[ci]))); }
    if (q == 0) ((float*)(F.ws + WS_GTOT))[(size_t)unit * 128 + k] = tot;
    __syncthreads();
    const int w = F.wave, fr = F.lane & 15, fq = F.lane >> 4;
    f32x4 acc[16];
#pragma unroll
    for (int i = 0; i < 16; ++i) acc[i] = (f32x4){0.f, 0.f, 0.f, 0.f};
#pragma unroll
    for (int ks = 0; ks < 2; ++ks) { const bf16x8 a = *(const LAS bf16x8*)(kdT + (16 * w + fr) * 72 + fq * 8 + 32 * ks);
#pragma unroll
        for (int nt = 0; nt < 16; ++nt) { const bf16x8 bb = *(const LAS bf16x8*)(vT + (16 * nt + fr) * 72 + fq * 8 + 32 * ks); acc[nt] = __builtin_amdgcn_mfma_f32_16x16x32_bf16(a, bb, acc[nt], 0, 0, 0); } }
    float* U = F.out + OUT_STATE / 4 + (size_t)unit * 128 * 256;
    __syncthreads();
    LAS float* uS = (LAS float*)F.lds;
#pragma unroll
    for (int nt = 0; nt < 16; ++nt)
#pragma unroll
        for (int j = 0; j < 4; ++j) uS[(16 * w + 4 * fq + j) * 260 + 16 * nt + fr] = acc[nt][j];
    __syncthreads();
#pragma unroll 4
    for (int i = 0; i < 16; ++i) { const int idx = tid + 512 * i, row = idx >> 6, c4 = idx & 63; *(f32x4*)(U + (size_t)row * 256 + 4 * c4) = *(const LAS f32x4*)(uS + row * 260 + 4 * c4); }
    __syncthreads();
}
__device__ __forceinline__ void gla_chain(const Frame& F) {
    const int gt = F.gw * 64 + F.lane;
    const float* GT = (const float*)(F.ws + WS_GTOT);
    for (int e = gt; e < 2 * 4 * 128 * 128; e += F.NGW * 64) {
        const int v2 = e & 127, k = (e >> 7) & 127, h = (e >> 14) & 3, b = e >> 16;
        f32x2 s = (f32x2){0.f, 0.f};
        for (int n0 = 0; n0 < 64; n0 += 8) {
            f32x2 u[8]; float d[8];
#pragma unroll
            for (int i = 0; i < 8; ++i) { const size_t un = ((size_t)(b * 64 + n0 + i) * 4 + h); u[i] = *(const f32x2*)(F.out + OUT_STATE / 4 + (un * 128 + k) * 256 + 2 * v2); d[i] = GT[un * 128 + k]; }
#pragma unroll
            for (int i = 0; i < 8; ++i) { const size_t un = ((size_t)(b * 64 + n0 + i) * 4 + h); const float dd = __expf(d[i]); s = s * dd + u[i]; *(f32x2*)(F.out + OUT_STATE / 4 + (un * 128 + k) * 256 + 2 * v2) = s; }
        }
    }
}
__device__ __forceinline__ void gla_o_unit(const Frame& F, int unit) {
    const int b = unit >> 8, n = (unit >> 2) & 63, h = unit & 3, tid = F.tid;
    const bf16* P = (const bf16*)(F.ws + WS_P); const size_t row0 = (size_t)b * SEQ + (size_t)n * 64;
    LAS bf16* sT = (LAS bf16*)F.lds;
    LAS bf16* qS = (LAS bf16*)(F.lds + 69632);
    LAS float* ssb = (LAS float*)(F.lds + 69632 + 17408);
    const float* ST = F.out + OUT_STATE / 4 + (size_t)unit * 128 * 256;
#pragma unroll 4
    for (int i = 0; i < 16; ++i) { const int idx = tid + 512 * i, rest = idx >> 6, k = (rest & 7) * 16 + (idx & 15), v4 = (rest >> 3) * 4 + ((idx >> 4) & 3); const f32x4 s = *(const f32x4*)(ST + (size_t)k * 256 + 4 * v4);
        LAS bf16* d = sT + (4 * v4) * 136 + k; d[0] = (bf16)f2bf(s.x); d[136] = (bf16)f2bf(s.y); d[272] = (bf16)f2bf(s.z); d[408] = (bf16)f2bf(s.w); }
#pragma unroll
    for (int i = 0; i < 2; ++i) { const int idx = tid + 512 * i, c = idx >> 4, k8 = idx & 15; *(LAS v4u*)(qS + c * 136 + 8 * k8) = *(const v4u*)(P + (row0 + c) * PW + PQ + h * 128 + 8 * k8); }
    __syncthreads();
    const int w = F.wave, fr = F.lane & 15, fq = F.lane >> 4;
    f32x4 acc[4][2];
#pragma unroll
    for (int mt = 0; mt < 4; ++mt) { acc[mt][0] = (f32x4){0.f, 0.f, 0.f, 0.f}; acc[mt][1] = (f32x4){0.f, 0.f, 0.f, 0.f}; }
#pragma unroll
    for (int ks = 0; ks < 4; ++ks) {
        bf16x8 bq[2];
#pragma unroll
        for (int nt = 0; nt < 2; ++nt) bq[nt] = *(const LAS bf16x8*)(sT + (32 * w + 16 * nt + fr) * 136 + fq * 8 + 32 * ks);
#pragma unroll
        for (int mt = 0; mt < 4; ++mt) { const bf16x8 a = *(const LAS bf16x8*)(qS + (16 * mt + fr) * 136 + fq * 8 + 32 * ks);
            acc[mt][0] = __builtin_amdgcn_mfma_f32_16x16x32_bf16(a, bq[0], acc[mt][0], 0, 0, 0); acc[mt][1] = __builtin_amdgcn_mfma_f32_16x16x32_bf16(a, bq[1], acc[mt][1], 0, 0, 0); }
    }
    const float sc = 0.08838834764831845f;
    __syncthreads();
    LAS float* oS = (LAS float*)F.lds;
#pragma unroll
    for (int mt = 0; mt < 4; ++mt)
#pragma unroll
        for (int j = 0; j < 4; ++j) { acc[mt][0][j] *= sc; acc[mt][1][j] *= sc; float ss = acc[mt][0][j] * acc[mt][0][j] + acc[mt][1][j] * acc[mt][1][j]; ss = allred16(ss);
            const int c = 16 * mt + 4 * fq + j; oS[c * 260 + 32 * w + fr] = acc[mt][0][j]; oS[c * 260 + 32 * w + 16 + fr] = acc[mt][1][j];
            if (fr == 0) ssb[w * 64 + c] = ss; }
    __syncthreads();
    const float* gn = F.in[I_GLA_GN]; bf16* OG = (bf16*)(F.ws + WS_OGLA);
    { const int c = tid >> 3, seg = tid & 7; float ss = 0.f;
#pragma unroll
      for (int ww = 0; ww < 8; ++ww) ss += ssb[ww * 64 + c];
      const float rstd = rsqrtf(ss * (1.0f / 256.0f) + 1e-6f);
      v4u rr[4];
#pragma unroll
      for (int i = 0; i < 4; ++i) rr[i] = *(const v4u*)(P + (row0 + c) * PW + PR + h * 256 + 64 * i + 8 * seg);
#pragma unroll
      for (int i = 0; i < 4; ++i) { const int v0 = 64 * i + 8 * seg; const f32x4 o0 = *(const LAS f32x4*)(oS + c * 260 + v0), o1 = *(const LAS f32x4*)(oS + c * 260 + v0 + 4);
          const f32x4 g0 = *(const f32x4*)(gn + v0), g1 = *(const f32x4*)(gn + v0 + 4);
          const float r[8] = {bflo(rr[i].x), bfhi(rr[i].x), bflo(rr[i].y), bfhi(rr[i].y), bflo(rr[i].z), bfhi(rr[i].z), bflo(rr[i].w), bfhi(rr[i].w)};
          float o[8] = {o0.x * g0.x, o0.y * g0.y, o0.z * g0.z, o0.w * g0.w, o1.x * g1.x, o1.y * g1.y, o1.z * g1.z, o1.w * g1.w};
#pragma unroll
          for (int e = 0; e < 8; ++e) o[e] *= rstd * (r[e] * sigmoidf_(r[e]));
          v4u wv; wv.x = pk2(o[0], o[1]); wv.y = pk2(o[2], o[3]); wv.z = pk2(o[4], o[5]); wv.w = pk2(o[6], o[7]);
          *(v4u*)(OG + (row0 + c) * 1024 + h * 256 + v0) = wv; } }
    __syncthreads();
}
constexpr int TC = 32, SBUF_F = 5 * TC * 64 + TC * 16;
#define LDS_BARRIER() do { asm volatile("s_waitcnt lgkmcnt(0)" ::: "memory"); __builtin_amdgcn_s_barrier(); asm volatile("" ::: "memory"); } while (0)
__device__ __forceinline__ void rwkv_scan_block(const Frame& F, int id) {
    const int b = id >> 6, h = (id >> 2) & 15, rg = id & 3, tid = F.tid;
    const bf16* P = (const bf16*)(F.ws + WS_P); const bf16* LO = (const bf16*)(F.ws + WS_LORA);
    LAS float* lds = (LAS float*)F.lds;
    const bool prod = tid >= 256;
    const int p = tid - 256, tt = (p >> 3) & 31, c8 = p & 7;
    float mur[8], muk[8], kkc[8], kac[8], muv[8];
    if (prod) {
#pragma unroll
        for (int j = 0; j < 8; ++j) { const int ch = h * 64 + 8 * c8 + j; mur[j] = F.in[I_MU][ch]; muk[j] = F.in[I_MU][1024 + ch]; kkc[j] = F.in[I_KK][ch]; kac[j] = F.in[I_KA][ch];
            muv[j] = F.in[I_MU][2048 + h * 64 + 16 * rg + 8 * (c8 & 1) + j]; }
    }
    v4u rc, rp, kc, kp, wv, av, vc, vp;
#define SCAN_ISSUE(c) do { const int t_ = (c) * TC + tt; const size_t row_ = (size_t)b * SEQ + t_; const size_t prow_ = t_ ? row_ - 1 : row_; \
        rc = *(const v4u*)(P + row_ * PW + RR + h * 64 + 8 * c8); rp = *(const v4u*)(P + prow_ * PW + RR + h * 64 + 8 * c8); \
        kc = *(const v4u*)(P + row_ * PW + RK + h * 64 + 8 * c8); kp = *(const v4u*)(P + prow_ * PW + RK + h * 64 + 8 * c8); \
        vc = *(const v4u*)(P + row_ * PW + RV + h * 64 + 16 * rg + 8 * (c8 & 1)); vp = *(const v4u*)(P + prow_ * PW + RV + h * 64 + 16 * rg + 8 * (c8 & 1)); \
        wv = *(const v4u*)(LO + row_ * NLORA + h * 64 + 8 * c8); av = *(const v4u*)(LO + row_ * NLORA + 1024 + h * 64 + 8 * c8); } while (0)
#define SCAN_FILL(c, bufp) do { const float pz_ = ((c) * TC + tt) ? 1.f : 0.f; LAS float* B_ = (bufp); \
        const unsigned rcw[4] = {rc.x, rc.y, rc.z, rc.w}, rpw[4] = {rp.x, rp.y, rp.z, rp.w}, kcw[4] = {kc.x, kc.y, kc.z, kc.w}, kpw[4] = {kp.x, kp.y, kp.z, kp.w}; \
        const unsigned wvw[4] = {wv.x, wv.y, wv.z, wv.w}, avw[4] = {av.x, av.y, av.z, av.w}, vcw[4] = {vc.x, vc.y, vc.z, vc.w}, vpw[4] = {vp.x, vp.y, vp.z, vp.w}; \
        float rs_[8], ks_[8], kr_[8], a_[8], w_[8], vs_[8]; float ss_ = 0.f; \
        _Pragma("unroll") for (int j = 0; j < 8; ++j) { const unsigned rcu = rcw[j >> 1], rpu = rpw[j >> 1], kcu = kcw[j >> 1], kpu = kpw[j >> 1], wu_ = wvw[j >> 1], au_ = avw[j >> 1], vcu = vcw[j >> 1], vpu = vpw[j >> 1]; \
            const float rcf = (j & 1) ? bfhi(rcu) : bflo(rcu), rpf = ((j & 1) ? bfhi(rpu) : bflo(rpu)) * pz_, kcf = (j & 1) ? bfhi(kcu) : bflo(kcu), kpf = ((j & 1) ? bfhi(kpu) : bflo(kpu)) * pz_; \
            const float vcf = (j & 1) ? bfhi(vcu) : bflo(vcu), vpf = ((j & 1) ? bfhi(vpu) : bflo(vpu)) * pz_; \
            rs_[j] = rcf + mur[j] * (rpf - rcf); ks_[j] = kcf + muk[j] * (kpf - kcf); vs_[j] = vcf + muv[j] * (vpf - vcf); kr_[j] = ks_[j] * kkc[j]; ss_ += kr_[j] * kr_[j]; \
            a_[j] = (j & 1) ? bfhi(au_) : bflo(au_); w_[j] = 1.0f - ((j & 1) ? bfhi(wu_) : bflo(wu_)); } \
        ss_ = allred8(ss_); const float inv_ = 1.0f / fmaxf(sqrtf(ss_), 1e-12f); \
        float km_[8], kk_[8], bb_[8]; \
        _Pragma("unroll") for (int j = 0; j < 8; ++j) { kk_[j] = kr_[j] * inv_; km_[j] = ks_[j] * (1.0f + (a_[j] - 1.0f) * kac[j]); bb_[j] = kk_[j] * a_[j]; } \
        const int o_ = tt * 64 + 8 * c8; \
        *(LAS f32x4*)(B_ + o_) = (f32x4){rs_[0], rs_[1], rs_[2], rs_[3]}; *(LAS f32x4*)(B_ + o_ + 4) = (f32x4){rs_[4], rs_[5], rs_[6], rs_[7]}; \
        *(LAS f32x4*)(B_ + TC * 64 + o_) = (f32x4){w_[0], w_[1], w_[2], w_[3]}; *(LAS f32x4*)(B_ + TC * 64 + o_ + 4) = (f32x4){w_[4], w_[5], w_[6], w_[7]}; \
        *(LAS f32x4*)(B_ + 2 * TC * 64 + o_) = (f32x4){km_[0], km_[1], km_[2], km_[3]}; *(LAS f32x4*)(B_ + 2 * TC * 64 + o_ + 4) = (f32x4){km_[4], km_[5], km_[6], km_[7]}; \
        *(LAS f32x4*)(B_ + 3 * TC * 64 + o_) = (f32x4){kk_[0], kk_[1], kk_[2], kk_[3]}; *(LAS f32x4*)(B_ + 3 * TC * 64 + o_ + 4) = (f32x4){kk_[4], kk_[5], kk_[6], kk_[7]}; \
        *(LAS f32x4*)(B_ + 4 * TC * 64 + o_) = (f32x4){bb_[0], bb_[1], bb_[2], bb_[3]}; *(LAS f32x4*)(B_ + 4 * TC * 64 + o_ + 4) = (f32x4){bb_[4], bb_[5], bb_[6], bb_[7]}; \
        if (c8 < 2) { *(LAS f32x4*)(B_ + 5 * TC * 64 + tt * 16 + 8 * c8) = (f32x4){vs_[0], vs_[1], vs_[2], vs_[3]}; *(LAS f32x4*)(B_ + 5 * TC * 64 + tt * 16 + 8 * c8 + 4) = (f32x4){vs_[4], vs_[5], vs_[6], vs_[7]}; } } while (0)
    constexpr int NCH = SEQ / TC;
    if (prod) { SCAN_ISSUE(0); SCAN_FILL(0, lds); SCAN_ISSUE(1); }
    LDS_BARRIER();
    const int rowl = (tid >> 4) & 15, kl = tid & 15;
    f32x2 S01 = (f32x2){0.f, 0.f}, S23 = (f32x2){0.f, 0.f};
    float ykeep = 0.f;
    float* Yp = (float*)(F.ws + WS_Y) + (size_t)b * SEQ * 1024 + h * 64 + 16 * rg + rowl + (size_t)kl * 1024;
    for (int c = 0; c < NCH; ++c) {
        if (prod) {
            if (c + 1 < NCH) { SCAN_FILL(c + 1, lds + ((c + 1) & 1) * SBUF_F); if (c + 2 < NCH) SCAN_ISSUE(c + 2); }
        } else {
            const LAS float* B = lds + (c & 1) * SBUF_F;
            const LAS f32x4* R4 = (const LAS f32x4*)B + kl; const LAS f32x4* W4 = (const LAS f32x4*)(B + TC * 64) + kl; const LAS f32x4* KM4 = (const LAS f32x4*)(B + 2 * TC * 64) + kl;
            const LAS f32x4* KK4 = (const LAS f32x4*)(B + 3 * TC * 64) + kl; const LAS f32x4* BB4 = (const LAS f32x4*)(B + 4 * TC * 64) + kl; const LAS float* V1 = B + 5 * TC * 64 + rowl;
            f32x4 kk = KK4[0], wv4 = W4[0], bb = BB4[0], km = KM4[0], r4 = R4[0]; float vv = V1[0];
#pragma unroll
            for (int t = 0; t < TC; ++t) {
                f32x4 kk_n = kk, wv_n = wv4, bb_n = bb, km_n = km, r_n = r4; float vv_n = vv;
                if (t + 1 < TC) { kk_n = KK4[(t + 1) * 16]; wv_n = W4[(t + 1) * 16]; bb_n = BB4[(t + 1) * 16]; km_n = KM4[(t + 1) * 16]; r_n = R4[(t + 1) * 16]; vv_n = V1[(t + 1) * 16]; }
                f32x2 d2 = S01 * (f32x2){kk.x, kk.y}; d2 = S23 * (f32x2){kk.z, kk.w} + d2;
                const f32x2 t01 = (f32x2){km.x, km.y} * vv, t23 = (f32x2){km.z, km.w} * vv;
                float sa = d2.x + d2.y; sa = allred16(sa);
                S01 = S01 * (f32x2){wv4.x, wv4.y} + (t01 - (f32x2){bb.x, bb.y} * sa);
                S23 = S23 * (f32x2){wv4.z, wv4.w} + (t23 - (f32x2){bb.z, bb.w} * sa);
                f32x2 y2 = S01 * (f32x2){r4.x, r4.y}; y2 = S23 * (f32x2){r4.z, r4.w} + y2;
                float y = y2.x + y2.y; y = allred16(y);
                ykeep = (kl == (t & 15)) ? y : ykeep;
                if ((t & 15) == 15) Yp[(size_t)(c * TC + t - 15) * 1024] = ykeep;
                kk = kk_n; wv4 = wv_n; bb = bb_n; km = km_n; r4 = r_n; vv = vv_n;
            }
        }
        LDS_BARRIER();
    }
#undef SCAN_ISSUE
#undef SCAN_FILL
}
typedef short bf16x4 __attribute__((ext_vector_type(4)));
#define MM32(a, b, c) __builtin_amdgcn_mfma_f32_16x16x32_bf16((a), (b), (c), 0, 0, 0)
typedef short bf16x4_fwd __attribute__((ext_vector_type(4)));
#define MM16_HW(a, b, c) __builtin_amdgcn_mfma_f32_16x16x16bf16_1k((a), (b), (c), 0, 0, 0)
__device__ __forceinline__ f32x4 mm16_emul(const bf16x4 a, const bf16x4 b, const f32x4 c) {
    const bf16x8 a8 = {a[0], a[1], a[2], a[3], 0, 0, 0, 0}, b8 = {b[0], b[1], b[2], b[3], 0, 0, 0, 0};
    return __builtin_amdgcn_mfma_f32_16x16x32_bf16(a8, b8, c, 0, 0, 0); }
#define MM16(a, b, c) mm16_emul((a), (b), (c))
typedef __bf16 bf16x2_t __attribute__((ext_vector_type(2)));
__device__ __forceinline__ unsigned cvtpk_c(float lo, float hi) { const f32x2 v = {lo, hi}; return __builtin_bit_cast(unsigned, __builtin_convertvector(v, bf16x2_t)); }
__device__ __forceinline__ bf16x4 pack4(const f32x4 v) { v2u r; r.x = cvtpk_c(v.x, v.y); r.y = cvtpk_c(v.z, v.w); return __builtin_bit_cast(bf16x4, r); }
__device__ __forceinline__ bf16x8 pack8(const f32x4 a, const f32x4 b) { v4u r; r.x = cvtpk_c(a.x, a.y); r.y = cvtpk_c(a.z, a.w); r.z = cvtpk_c(b.x, b.y); r.w = cvtpk_c(b.z, b.w); return __builtin_bit_cast(bf16x8, r); }
constexpr size_t Z_UNIT = 12800, WS_Z = 1 * MiB, WS_Y2 = WS_H;
constexpr int PRE_LDS_WAVE = 6912;
__device__ __forceinline__ void rwkv_pre(const Frame& F) {
    const int lane = F.lane, q = lane >> 4, c15 = lane & 15;
    const int bh = F.gw & 31, b = bh >> 4, h = bh & 15;
    const bf16* P = (const bf16*)(F.ws + WS_P); const bf16* LO = (const bf16*)(F.ws + WS_LORA);
    LAS bf16* KKs = (LAS bf16*)(F.lds + F.wave * PRE_LDS_WAVE); LAS bf16* Bs = KKs + 1088; LAS bf16* KMs = KKs + 2176; LAS float* gTs = (LAS float*)(KKs + 3264);
    float mur[16], muk[16], kkc[16], kac[16];
#pragma unroll
    for (int e = 0; e < 16; ++e) { const int ch = h * 64 + 16 * (e >> 2) + 4 * q + (e & 3); mur[e] = F.in[I_MU][ch]; muk[e] = F.in[I_MU][1024 + ch]; kkc[e] = F.in[I_KK][ch]; kac[e] = F.in[I_KA][ch]; }
    const f32x4 z4 = (f32x4){0.f, 0.f, 0.f, 0.f};
    for (int c = F.gw >> 5; c < 256; c += F.NGW >> 5) {
        const int t = 16 * c + c15; const size_t row = (size_t)b * SEQ + t, prow = t ? row - 1 : row; const float pz = t ? 1.f : 0.f;
        float rs[16], kk[16], km[16], bb[16], lw[16]; float ssq = 0.f;
#pragma unroll
        for (int a = 0; a < 4; ++a) {
            const int co = h * 64 + 16 * a + 4 * q;
            const v2u rc = *(const v2u*)(P + row * PW + RR + co), rp = *(const v2u*)(P + prow * PW + RR + co), kc = *(const v2u*)(P + row * PW + RK + co), kp = *(const v2u*)(P + prow * PW + RK + co);
            const v2u wv = *(const v2u*)(LO + row * NLORA + co), av = *(const v2u*)(LO + row * NLORA + 1024 + co);
            const float rcf[4] = {bflo(rc.x), bfhi(rc.x), bflo(rc.y), bfhi(rc.y)}, rpf[4] = {bflo(rp.x), bfhi(rp.x), bflo(rp.y), bfhi(rp.y)};
            const float kcf[4] = {bflo(kc.x), bfhi(kc.x), bflo(kc.y), bfhi(kc.y)}, kpf[4] = {bflo(kp.x), bfhi(kp.x), bflo(kp.y), bfhi(kp.y)};
            const float wf[4] = {bflo(wv.x), bfhi(wv.x), bflo(wv.y), bfhi(wv.y)}, af[4] = {bflo(av.x), bfhi(av.x), bflo(av.y), bfhi(av.y)};
#pragma unroll
            for (int i = 0; i < 4; ++i) { const int e = 4 * a + i;
                rs[e] = rcf[i] + mur[e] * (rpf[i] * pz - rcf[i]); const float ks = kcf[i] + muk[e] * (kpf[i] * pz - kcf[i]);
                const float kr = ks * kkc[e]; ssq += kr * kr; kk[e] = kr; bb[e] = af[i]; km[e] = ks * (1.0f + (af[i] - 1.0f) * kac[e]); lw[e] = __logf(1.0f - wf[i]); }
        }
        ssq += __shfl_xor(ssq, 16); ssq += __shfl_xor(ssq, 32);
        const float inv = 1.0f / fmaxf(sqrtf(ssq), 1e-12f);
        float KKt[16], Bt[16], KMt[16], Rt[16];
#pragma unroll
        for (int e = 0; e < 16; ++e) {
            float cum = lw[e]; cum += dppf<0x111>(cum); cum += dppf<0x112>(cum); cum += dppf<0x114>(cum); cum += dppf<0x118>(cum);
            const float g = __expf(cum), gm1 = __expf(cum - lw[e]), ig = __expf(-cum);
            const float kkn = kk[e] * inv;
            KKt[e] = gm1 * kkn; Bt[e] = kkn * bb[e] * ig; KMt[e] = km[e] * ig; Rt[e] = g * rs[e];
            if (c15 == 15) gTs[16 * (e >> 2) + 4 * q + (e & 3)] = g;
        }
#pragma unroll
        for (int a = 0; a < 4; ++a) { const int o = c15 * 68 + 16 * a + 4 * q;
            v2u w; w.x = cvtpk_c(KKt[4 * a], KKt[4 * a + 1]); w.y = cvtpk_c(KKt[4 * a + 2], KKt[4 * a + 3]); *(LAS v2u*)(KKs + o) = w;
            w.x = cvtpk_c(Bt[4 * a], Bt[4 * a + 1]); w.y = cvtpk_c(Bt[4 * a + 2], Bt[4 * a + 3]); *(LAS v2u*)(Bs + o) = w;
            w.x = cvtpk_c(KMt[4 * a], KMt[4 * a + 1]); w.y = cvtpk_c(KMt[4 * a + 2], KMt[4 * a + 3]); *(LAS v2u*)(KMs + o) = w; }
        bf16x8 KK8[2], B8[2], KM8[2], R8[2];
#pragma unroll
        for (int s = 0; s < 2; ++s) {
            KK8[s] = pack8((f32x4){KKt[8 * s], KKt[8 * s + 1], KKt[8 * s + 2], KKt[8 * s + 3]}, (f32x4){KKt[8 * s + 4], KKt[8 * s + 5], KKt[8 * s + 6], KKt[8 * s + 7]});
            B8[s] = pack8((f32x4){Bt[8 * s], Bt[8 * s + 1], Bt[8 * s + 2], Bt[8 * s + 3]}, (f32x4){Bt[8 * s + 4], Bt[8 * s + 5], Bt[8 * s + 6], Bt[8 * s + 7]});
            KM8[s] = pack8((f32x4){KMt[8 * s], KMt[8 * s + 1], KMt[8 * s + 2], KMt[8 * s + 3]}, (f32x4){KMt[8 * s + 4], KMt[8 * s + 5], KMt[8 * s + 6], KMt[8 * s + 7]});
            R8[s] = pack8((f32x4){Rt[8 * s], Rt[8 * s + 1], Rt[8 * s + 2], Rt[8 * s + 3]}, (f32x4){Rt[8 * s + 4], Rt[8 * s + 5], Rt[8 * s + 6], Rt[8 * s + 7]});
        }
        f32x4 M1T = MM32(KK8[1], KM8[1], MM32(KK8[0], KM8[0], z4));
        f32x4 X = MM32(B8[1], KK8[1], MM32(B8[0], KK8[0], z4));
        f32x4 XT = MM32(KK8[1], B8[1], MM32(KK8[0], B8[0], z4));
        f32x4 N1 = MM32(KM8[1], R8[1], MM32(KM8[0], R8[0], z4));
        f32x4 N2 = MM32(B8[1], R8[1], MM32(B8[0], R8[0], z4));
        f32x4 W, WT;
#pragma unroll
        for (int i = 0; i < 4; ++i) { const int r4 = 4 * q + i; const float id = (r4 == c15) ? 1.f : 0.f;
            M1T[i] = (c15 < r4) ? M1T[i] : 0.f; X[i] = (r4 < c15) ? -X[i] : 0.f; XT[i] = (c15 < r4) ? -XT[i] : 0.f; N1[i] = (r4 <= c15) ? N1[i] : 0.f; N2[i] = (r4 <= c15) ? N2[i] : 0.f;
            W[i] = id + X[i]; WT[i] = id + XT[i]; }
#pragma unroll
        for (int lvl = 0; lvl < 3; ++lvl) {
            const bf16x4 xp = pack4(X), xtp = pack4(XT), wtp = pack4(WT);
            const f32x4 X2 = MM16(xtp, xp, z4), XT2 = MM16(xp, xtp, z4);
            const bf16x4 x2p = pack4(X2);
            W = MM16(wtp, x2p, W); WT = MM16(x2p, wtp, WT);
            X = X2; XT = XT2;
        }
        const bf16x4 wtp = pack4(WT), m1p = pack4(M1T);
        const f32x4 WN2 = MM16(wtp, pack4(N2), z4);
        const bf16x4 wn2p = pack4(WN2);
        const f32x4 Th = N1 - MM16(m1p, wn2p, z4);
        asm volatile("s_waitcnt lgkmcnt(0)" ::: "memory");
        bf16x4 KKT[4], BT[4]; float KMTf[4][4], gTv[4];
#pragma unroll
        for (int a = 0; a < 4; ++a) {
            bf16x4 k4, b4;
#pragma unroll
            for (int i = 0; i < 4; ++i) { const int o = (4 * q + i) * 68 + 16 * a + c15; k4[i] = (short)KKs[o]; b4[i] = (short)Bs[o]; KMTf[a][i] = bf1(KMs[o]); }
            KKT[a] = k4; BT[a] = b4; gTv[a] = gTs[16 * a + c15];
        }
        unsigned char* Zu = F.ws + WS_Z + (size_t)(bh * 256 + c) * Z_UNIT;
        bf16x4 wbp[4];
#pragma unroll
        for (int a = 0; a < 4; ++a) { const f32x4 WB = MM16(wtp, BT[a], z4); wbp[a] = pack4(WB);
            f32x4 Ps = MM16(m1p, wbp[a], z4);
#pragma unroll
            for (int i = 0; i < 4; ++i) Ps[i] = (KMTf[a][i] - Ps[i]) * gTv[a];
            *(bf16x4*)(Zu + 8192 + (a * 64 + lane) * 8) = pack4(Ps); }
        f32x4 Om[4];
#pragma unroll
        for (int a = 0; a < 4; ++a) { const f32x4 mm = MM16(KKT[a], wn2p, z4);
#pragma unroll
            for (int i = 0; i < 4; ++i) Om[a][i] = Rt[4 * a + i] - mm[i]; }
        *(bf16x8*)(Zu + 10240 + (0 * 64 + lane) * 16) = pack8(Om[0], Om[1]); *(bf16x8*)(Zu + 10240 + (1 * 64 + lane) * 16) = pack8(Om[2], Om[3]);
        *(bf16x4*)(Zu + 12288 + lane * 8) = pack4(Th);
#pragma unroll
        for (int bt = 0; bt < 4; ++bt) {
            f32x4 Ph[4];
#pragma unroll
            for (int a = 0; a < 4; ++a) { const f32x4 mm = MM16(KKT[a], wbp[bt], z4);
#pragma unroll
                for (int i = 0; i < 4; ++i) Ph[a][i] = (((16 * a + 4 * q + i) == (16 * bt + c15) ? 1.f : 0.f) - mm[i]) * gTv[bt]; }
            *(bf16x8*)(Zu + ((bt * 2 + 0) * 64 + lane) * 16) = pack8(Ph[0], Ph[1]); *(bf16x8*)(Zu + ((bt * 2 + 1) * 64 + lane) * 16) = pack8(Ph[2], Ph[3]);
        }
        asm volatile("s_waitcnt lgkmcnt(0)" ::: "memory");
    }
}
constexpr int GC = 4, CH_LDS = 12800 + 17 * 128, NGRP = 256 / GC, ZP = GC * 800, VP = GC * 136, ZL = (ZP + 255) / 256, VL = (VP + 255) / 256;
__device__ __forceinline__ void rwkv_apply(const Frame& F, int bh) {
    const int lane = F.lane, q = lane >> 4, c15 = lane & 15, b = bh >> 4, h = bh & 15, w = F.wave & 3;
    const bool loader = F.wave >= 4; const int l256 = F.tid & 255;
    const unsigned char* Zb = F.ws + WS_Z + (size_t)bh * 256 * Z_UNIT;
    const bf16* Pv = (const bf16*)(F.ws + WS_P) + (size_t)b * SEQ * PW + RV + h * 64;
    LAS unsigned char* ring = F.lds;
    v4u zrA[ZL], vrA[VL], zrB[ZL], vrB[VL];
#define AP_ISSUE(g, zr, vr) do { _Pragma("unroll") for (int k = 0; k < ZL; ++k) { int p = l256 + 256 * k; p = p < ZP ? p : ZP - 1; const int j = p / 800, off = p - j * 800; zr[k] = *(const v4u*)(Zb + (size_t)((g) * GC + j) * Z_UNIT + off * 16); } \
        _Pragma("unroll") for (int k = 0; k < VL; ++k) { int p = l256 + 256 * k; p = p < VP ? p : VP - 1; const int j = p / 136, r = p - j * 136, tok = r >> 3, pc = r & 7; int t = 16 * ((g) * GC + j) - 1 + tok; t = t < 0 ? 0 : t; \
            vr[k] = *(const v4u*)(Pv + (size_t)t * PW + 8 * pc); } } while (0)
#define AP_WRITE(bufi, zr, vr) do { LAS unsigned char* B_ = ring + (bufi) * (GC * CH_LDS); _Pragma("unroll") for (int k = 0; k < ZL; ++k) { const int p = l256 + 256 * k; if (p < ZP) { const int j = p / 800, off = p - j * 800; *(LAS v4u*)(B_ + j * CH_LDS + off * 16) = zr[k]; } } \
        _Pragma("unroll") for (int k = 0; k < VL; ++k) { const int p = l256 + 256 * k; if (p < VP) { const int j = p / 136, r = p - j * 136; *(LAS v4u*)(B_ + j * CH_LDS + 12800 + r * 16) = vr[k]; } } } while (0)
    if (loader) {
        AP_ISSUE(0, zrA, vrA); AP_ISSUE(1, zrB, vrB); AP_WRITE(0, zrA, vrA); AP_ISSUE(2, zrA, vrA);
        LDS_BARRIER();
        for (int g = 0; g < NGRP; g += 2) {
            if (g + 1 < NGRP) { AP_WRITE(1, zrB, vrB); if (g + 3 < NGRP) AP_ISSUE(g + 3, zrB, vrB); }
            LDS_BARRIER();
            if (g + 2 < NGRP) { AP_WRITE(0, zrA, vrA); if (g + 4 < NGRP) AP_ISSUE(g + 4, zrA, vrA); }
            LDS_BARRIER();
        }
    } else {
        const float muv = F.in[I_MU][2048 + h * 64 + 16 * w + c15];
        bf16* Yb = (bf16*)(F.ws + WS_Y2) + (size_t)b * SEQ * 1024 + h * 64 + 16 * w + c15;
        const f32x4 z4 = (f32x4){0.f, 0.f, 0.f, 0.f};
        f32x4 S[4] = {z4, z4, z4, z4};
        LDS_BARRIER();
        for (int g = 0; g < NGRP; ++g) {
            const LAS unsigned char* B = ring + (g & 1) * (GC * CH_LDS);
            bf16x8 oPh[4][2], oOm[2]; bf16x4 oPs[4], oTh; float ovr[5];
#define AP_LD(Zu_) do { const LAS unsigned char* Z_ = (Zu_); _Pragma("unroll") for (int ao = 0; ao < 4; ++ao) { oPh[ao][0] = *(const LAS bf16x8*)(Z_ + ((ao * 2 + 0) * 64 + lane) * 16); oPh[ao][1] = *(const LAS bf16x8*)(Z_ + ((ao * 2 + 1) * 64 + lane) * 16); \
                oPs[ao] = *(const LAS bf16x4*)(Z_ + 8192 + (ao * 64 + lane) * 8); } oOm[0] = *(const LAS bf16x8*)(Z_ + 10240 + lane * 16); oOm[1] = *(const LAS bf16x8*)(Z_ + 10240 + (64 + lane) * 16); oTh = *(const LAS bf16x4*)(Z_ + 12288 + lane * 8); \
                const LAS bf16* Vs_ = (const LAS bf16*)(Z_ + 12800) + 16 * w + c15; _Pragma("unroll") for (int n = 0; n < 5; ++n) ovr[n] = bf1(Vs_[(4 * q + n) * 64]); } while (0)
            AP_LD(B);
#pragma unroll
            for (int j = 0; j < GC; ++j) {
                const int c = g * GC + j;
                bf16x8 Ph[4][2], Om[2]; bf16x4 Ps[4], Th; float vraw[5];
#pragma unroll
                for (int ao = 0; ao < 4; ++ao) { Ph[ao][0] = oPh[ao][0]; Ph[ao][1] = oPh[ao][1]; Ps[ao] = oPs[ao]; }
                Om[0] = oOm[0]; Om[1] = oOm[1]; Th = oTh;
#pragma unroll
                for (int n = 0; n < 5; ++n) vraw[n] = ovr[n];
                if (j + 1 < GC) { AP_LD(B + (j + 1) * CH_LDS); }
                __builtin_amdgcn_sched_barrier(0);
                if (c == 0 && q == 0) vraw[0] = 0.f;
                f32x4 vs;
#pragma unroll
                for (int i = 0; i < 4; ++i) vs[i] = vraw[i + 1] + muv * (vraw[i] - vraw[i + 1]);
                const bf16x4 BV = pack4(vs);
                const bf16x8 Sb0 = pack8(S[0], S[1]), Sb1 = pack8(S[2], S[3]);
                f32x4 y = MM16(Th, BV, z4), n0 = MM16(Ps[0], BV, z4), n1 = MM16(Ps[1], BV, z4), n2 = MM16(Ps[2], BV, z4), n3 = MM16(Ps[3], BV, z4);
                y = MM32(Om[0], Sb0, y); n0 = MM32(Ph[0][0], Sb0, n0); n1 = MM32(Ph[1][0], Sb0, n1); n2 = MM32(Ph[2][0], Sb0, n2); n3 = MM32(Ph[3][0], Sb0, n3);
                y = MM32(Om[1], Sb1, y); n0 = MM32(Ph[0][1], Sb1, n0); n1 = MM32(Ph[1][1], Sb1, n1); n2 = MM32(Ph[2][1], Sb1, n2); n3 = MM32(Ph[3][1], Sb1, n3);
                S[0] = n0; S[1] = n1; S[2] = n2; S[3] = n3;
                const int t0 = 16 * c + 4 * q;
#pragma unroll
                for (int i = 0; i < 4; ++i) Yb[(size_t)(t0 + i) * 1024] = (bf16)f2bf(y[i]);
            }
#undef AP_LD
            LDS_BARRIER();
        }
    }
#undef AP_ISSUE
#undef AP_WRITE
}
__device__ __forceinline__ void unpack8(const v4u u, float (&f)[8]) { f[0] = bflo(u.x); f[1] = bfhi(u.x); f[2] = bflo(u.y); f[3] = bfhi(u.y); f[4] = bflo(u.z); f[5] = bfhi(u.z); f[6] = bflo(u.w); f[7] = bfhi(u.w); }
__device__ __forceinline__ void rwkv_post(const Frame& F) {
    const bf16* P = (const bf16*)(F.ws + WS_P); const bf16* LO = (const bf16*)(F.ws + WS_LORA); const bf16* Y = (const bf16*)(F.ws + WS_Y2); bf16* OR = (bf16*)(F.ws + WS_ORW);
    const int h = F.gw & 15, sub = F.lane & 7, tk = F.lane >> 3, ch0 = h * 64 + 8 * sub;
    float mur[8], muk[8], muv[8], ka[8], rk[8], lw[8], lb[8];
#pragma unroll
    for (int j = 0; j < 8; ++j) { const int ch = ch0 + j; mur[j] = F.in[I_MU][ch]; muk[j] = F.in[I_MU][1024 + ch]; muv[j] = F.in[I_MU][2048 + ch]; ka[j] = F.in[I_KA][ch]; rk[j] = F.in[I_RK][ch]; lw[j] = F.in[I_LNW][ch]; lb[j] = F.in[I_LNB][ch]; }
    for (int m = (F.gw >> 4) * 8 + tk; m < M; m += (F.NGW >> 4) * 8) {
        const bool first = (m % SEQ) == 0; const size_t row = m, prow = first ? m : m - 1; const float pz = first ? 0.f : 1.f;
        float rc[8], rp[8], kc[8], kp[8], vc[8], vp[8], av[8], gv[8], yv[8];
        unpack8(*(const v4u*)(P + row * PW + RR + ch0), rc); unpack8(*(const v4u*)(P + prow * PW + RR + ch0), rp); unpack8(*(const v4u*)(P + row * PW + RK + ch0), kc); unpack8(*(const v4u*)(P + prow * PW + RK + ch0), kp);
        unpack8(*(const v4u*)(P + row * PW + RV + ch0), vc); unpack8(*(const v4u*)(P + prow * PW + RV + ch0), vp);
        unpack8(*(const v4u*)(LO + row * NLORA + 1024 + ch0), av); unpack8(*(const v4u*)(LO + row * NLORA + 2048 + ch0), gv); unpack8(*(const v4u*)(Y + row * 1024 + ch0), yv);
        float dot = 0.f, sum = 0.f, vs[8];
#pragma unroll
        for (int j = 0; j < 8; ++j) { const float rs = rc[j] + mur[j] * (rp[j] * pz - rc[j]), ks = kc[j] + muk[j] * (kp[j] * pz - kc[j]); vs[j] = vc[j] + muv[j] * (vp[j] * pz - vc[j]);
            dot += rs * (ks * (1.0f + (av[j] - 1.0f) * ka[j])) * rk[j]; sum += yv[j]; }
        dot = allred8(dot); const float mean = allred8(sum) * (1.0f / 64.0f);
        float sq = 0.f;
#pragma unroll
        for (int j = 0; j < 8; ++j) { yv[j] -= mean; sq += yv[j] * yv[j]; }
        const float rstd = rsqrtf(allred8(sq) * (1.0f / 64.0f) + 64e-5f);
        float o[8];
#pragma unroll
        for (int j = 0; j < 8; ++j) o[j] = (yv[j] * rstd * lw[j] + lb[j] + dot * vs[j]) * gv[j];
        v4u w; w.x = pk2(o[0], o[1]); w.y = pk2(o[2], o[3]); w.z = pk2(o[4], o[5]); w.w = pk2(o[6], o[7]);
        *(v4u*)(OR + row * 1024 + ch0) = w;
    }
}
#ifndef MK_SPLIT
#define MK_SPLIT 0
#endif
constexpr int NPHASE = 15;
struct Args { const float* in[29]; float* out; unsigned char* ws; int ph_lo, ph_hi; };
__global__ void __launch_bounds__(512, 2) fwd_mega(Args args) {
    extern __shared__ __attribute__((aligned(16))) unsigned char lds_raw[];
    cg::grid_group grid = cg::this_grid();
    Frame F;
    F.lds = (LAS unsigned char*)lds_raw;
    F.tid = threadIdx.x; F.lane = F.tid & 63; F.wave = __builtin_amdgcn_readfirstlane(F.tid >> 6);
    F.G = gridDim.x; F.gw = blockIdx.x * 8 + F.wave; F.NGW = F.G * 8;
#pragma unroll
    for (int i = 0; i < 29; ++i) F.in[i] = args.in[i];
    F.out = args.out; F.ws = args.ws;
    unsigned char* ws = args.ws;
    const int lo = args.ph_lo, hi = args.ph_hi, bid = blockIdx.x;
    volatile LAS unsigned* xst = (volatile LAS unsigned*)(F.lds + LDS_BYTES - 64);
    if (F.tid == 0) { xst[0] = 0u; xst[1] = 0u; }
    unsigned* barw = (unsigned*)(ws + WS_BAR);
    if (bid == 0) for (int i = F.tid; i < XCD_BAR_WORDS; i += 512) barw[i] = 0u;
    __syncthreads();
    bf16* H = (bf16*)(ws + WS_H); float* X1 = (float*)(ws + WS_X1); bf16* Pb = (bf16*)(ws + WS_P); bf16* ACT = (bf16*)(ws + WS_ACT);
#define IN(k) (lo <= (k) && (k) < hi)
#define SEAM(k) xcd_barrier(xbar)
#define SEAM2(k) xcd_barrier(xbar)
#define GEMM_PHASE(EPI, Aptr, Bptr, N_, K_, ...) do { pg8::Gemm g{(const pg8::bf16_t*)(Aptr), (const pg8::bf16_t*)(Bptr), M, (N_), (K_)}; pg8::StaticOrder S; S.init(M, (N_), F.G, bid); \
        EPI E{__VA_ARGS__}; pg8::gemm_phase<EPI, pg8::StaticOrder, true, true>(F.lds, g, S, E); } while (0)

    if (IN(0)) { p_prologue(F); }
    grid.sync();
    const XcdBarrier xbar = xcd_barrier_post(barw, xst);
    if (IN(1)) { GEMM_PHASE(pg8::EpiSwiglu, H, ws + WS_WUP, NUP, D, ACT, FF, nullptr);
        { const int nfull = (32 * (NUP / 256)) % F.G, ne = F.G - nfull; const bool early = nfull && bid >= nfull; const int w0 = early ? (bid - nfull) * 8 + F.wave : F.gw, nw = nfull ? ne * 8 : F.NGW;
          if (early || !nfull) { convert_ffn_dn(F, 0, (bf16*)(ws + WS_WDN), w0, nw); tr_job(F, SrcWin{F.in[I_WIN]}, D_IN, (bf16*)(ws + WS_WIN), D, PW, w0, nw); } } } SEAM(1);
    if (IN(2)) { GEMM_PHASE(pg8::EpiResid, ACT, ws + WS_WDN, D, FF, F.in[I_X], X1, D, 0.5f, H, F.in[I_NMIX], (float*)(ws + WS_SS1)); } SEAM2(2);
    if (IN(4)) { GEMM_PHASE(pg8::EpiWin, H, ws + WS_WIN, PW, D, Pb, PW, F.in[I_GATEB], GG / 256, SM / 256, (const float*)(ws + WS_SS1));
        { const int nfull = (32 * (PW / 256)) % F.G, ne = F.G - nfull; const bool early = nfull && bid >= nfull; const int w0 = early ? (bid - nfull) * 8 + F.wave : F.gw, nw = nfull ? ne * 8 : F.NGW;
          if (early || !nfull) { tr_job(F, SrcPlain{F.in[I_WBR]}, D, (bf16*)(ws + WS_WBR1), 1024, D, w0, nw); tr_job(F, SrcPlain{F.in[I_WBR] + (size_t)1024 * D}, D, (bf16*)(ws + WS_WBR2), 1024, D, w0, nw);
              tr_job(F, SrcPlain{F.in[I_WOUT]}, D, (bf16*)(ws + WS_WOUT), D, D, w0, nw); } } } SEAM(4);
    if (IN(5)) { p_lora_a(F); for (int u = bid; u < 512; u += F.G) gla_u_unit(F, u); } SEAM(5);
    if (IN(6)) { { int klora = 256; asm volatile("" : "+s"(klora));
          pg8::Gemm g{(const pg8::bf16_t*)(ws + WS_ALORA), (const pg8::bf16_t*)(ws + WS_WLORA), M, NLORA, klora}; pg8::LoraOrder S; S.S.init(M, NLORA, F.G, bid);
          pg8::EpiLora E{(bf16*)(ws + WS_LORA), NLORA, F.in[I_W0], F.in[I_A0]}; pg8::gemm_phase<pg8::EpiLora, pg8::LoraOrder, true, true>(F.lds, g, S, E); }
        gla_chain(F); } SEAM(6);
    if (IN(7)) {
        rwkv_pre(F); __syncthreads();
        for (int u = bid; u < 512; u += F.G) gla_o_unit(F, u);
        xcd_barrier(xbar);
        if (F.G > 64) { if (bid < 32) rwkv_apply(F, bid);
            else { convert_ffn_up(F, 1, (bf16*)args.out, (bid - 32) * 8 + F.wave, (F.G - 32) * 8); __syncthreads();
                pg8::Gemm g{(const pg8::bf16_t*)(ws + WS_OGLA), (const pg8::bf16_t*)(ws + WS_WBR1), M, D, 1024}; pg8::StaticOrder S; S.init(M, D, F.G - 32, bid - 32);
                pg8::EpiGate<false> E{Pb + GG, PW, Pb + GG, PW}; pg8::gemm_phase<pg8::EpiGate<false>, pg8::StaticOrder, true, true>(F.lds, g, S, E); } }
        else { for (int id = bid; id < 32; id += F.G) rwkv_apply(F, id); convert_ffn_up(F, 1, (bf16*)args.out, F.gw, F.NGW); __syncthreads();
            GEMM_PHASE(pg8::EpiGate<false>, ws + WS_OGLA, ws + WS_WBR1, D, 1024, Pb + GG, PW, Pb + GG, PW); }
    } SEAM(7);
    if (IN(8)) { rwkv_post(F); } SEAM(8);
    if (IN(9)) {
        GEMM_PHASE(pg8::EpiGate<true>, ws + WS_ORW, ws + WS_WBR2, D, 1024, Pb + GR, PW, Pb + GG, PW);
    } SEAM(9);
    if (IN(10)) { pg8::Gemm g{(const pg8::bf16_t*)(Pb + GG), (const pg8::bf16_t*)(ws + WS_WOUT), M, D, D, PW, 0}; pg8::StaticOrder S; S.init(M, D, F.G, bid);
        pg8::EpiResid E{X1, X1, D, 1.0f, H, F.in[I_N2], (float*)(ws + WS_SS2)}; pg8::gemm_phase<pg8::EpiResid, pg8::StaticOrder, true, true>(F.lds, g, S, E); } SEAM2(10);
    if (IN(12)) { GEMM_PHASE(pg8::EpiSwiglu, H, args.out, NUP, D, ACT, FF, (const float*)(ws + WS_SS2));
        { const int nfull = (32 * (NUP / 256)) % F.G, ne = F.G - nfull; const bool early = nfull && bid >= nfull; const int w0 = early ? (bid - nfull) * 8 + F.wave : F.gw, nw = nfull ? ne * 8 : F.NGW;
          if (early || !nfull) convert_ffn_dn(F, 1, (bf16*)(ws + WS_WDN2), w0, nw); } } SEAM(12);
    if (F.G == 256) {
        pg8::Gemm g{(const pg8::bf16_t*)ACT, (const pg8::bf16_t*)(ws + WS_WDN2), M, D, FF}; pg8::StaticOrder S; S.init(M, D, F.G, bid);
        EpiFinalBar E{X1, args.out, D, 0.5f, F.in[I_NF], (float*)(ws + WS_SS3), xbar}; pg8::gemm_phase<EpiFinalBar, pg8::StaticOrder, true, true>(F.lds, g, S, E);
    } else {
        if (IN(13)) { GEMM_PHASE(pg8::EpiResid, ACT, ws + WS_WDN2, D, FF, X1, nullptr, D, 0.5f, H, F.in[I_NF], (float*)(ws + WS_SS3)); } SEAM(13);
        if (IN(14)) { final_scale(F, H, (const float*)(ws + WS_SS3), args.out); }
    }
#undef IN
#undef SEAM
#undef GEMM_PHASE
}

extern "C" void kernel_launch(void* const* d_in, const int* in_sizes, int n_in, void* d_out, int out_size, void* d_ws, size_t ws_size, hipStream_t stream) {
    static int grid = 0;
    if (grid == 0) {
        if (n_in != 29 || out_size != M * D || ws_size < WS_END) { fprintf(stderr, "kernel_launch: unexpected shapes (n_in %d out %d ws %zu)\n", n_in, out_size, ws_size); grid = -1; return; }
        int dev = 0, cus = 0, per_cu = 0;
        hipGetDevice(&dev); hipDeviceGetAttribute(&cus, hipDeviceAttributeMultiprocessorCount, dev);
        hipFuncSetAttribute((const void*)fwd_mega, hipFuncAttributeMaxDynamicSharedMemorySize, LDS_BYTES);
        if (hipOccupancyMaxActiveBlocksPerMultiprocessor(&per_cu, (const void*)fwd_mega, 512, LDS_BYTES) != hipSuccess || per_cu < 1) { fprintf(stderr, "kernel_launch: occupancy query says %d blocks per CU\n", per_cu); (void)hipGetLastError(); per_cu = 1; }
        grid = cus * (per_cu > 1 ? 1 : per_cu);
        fprintf(stderr, "kernel_launch: grid %d (cus %d, per_cu %d), ws %zu\n", grid, cus, per_cu, ws_size);
    }
    if (grid < 0) return;
    Args a{};
    for (int i = 0; i < 29; ++i) a.in[i] = (const float*)d_in[i];
    a.out = (float*)d_out; a.ws = (unsigned char*)d_ws;
#if MK_SPLIT
    for (int p = 0; p < NPHASE; ++p) { a.ph_lo = p; a.ph_hi = p + 1; hipLaunchKernelGGL(fwd_mega, dim3(grid), dim3(512), LDS_BYTES, stream, a); }
#else
    a.ph_lo = 0; a.ph_hi = NPHASE;
    void* kargs[] = {&a};
    hipError_t e = hipLaunchCooperativeKernel((void*)fwd_mega, dim3(grid), dim3(512), kargs, LDS_BYTES, stream);
    if (e != hipSuccess) fprintf(stderr, "kernel_launch: cooperative launch failed: %s (grid %d)\n", hipGetErrorString(e), grid);
#endif
}
```
